# Optimizing an MI355X kernel written in HIP

```python
import jax, jax.numpy as jnp
from jax import lax
import numpy as np

D_MODEL = 1024
BATCH = 8
SEQ = 4096
DEPTH = 2

N_META = 16
RET_HEADS = 4
RET_HEAD_DIM = 128
RET_WIDTH = RET_HEADS * RET_HEAD_DIM
POOL_WINDOWS = (2, 4, 8, 16)
POOL_GROUPS = len(POOL_WINDOWS)
POOL_GROUP_DIM = 128
POOL_WIDTH = POOL_GROUPS * POOL_GROUP_DIM
CHUNK = 128
D_FF = 2816
ROPE_BASE = 10000.0
EPS = 1e-6
N_IN = 4 * RET_WIDTH + POOL_WIDTH + 2 * D_MODEL

kernel_name = 'hybrid_retention_pool_macaron'


def _rmsnorm(x, g):
    xf = x.astype(jnp.float32)
    y = xf * lax.rsqrt(jnp.mean(xf * xf, axis=-1, keepdims=True) + EPS)
    return (y * g.astype(jnp.float32)).astype(x.dtype)


def _swiglu(h, w_gate, w_up, w_down):
    return (jax.nn.silu(h @ w_gate) * (h @ w_up)) @ w_down


def _rotary(t, pos):
    half = t.shape[-1] // 2
    inv_freq = ROPE_BASE ** (-jnp.arange(half, dtype=jnp.float32) / half)
    ang = pos[:, None] * inv_freq[None, :]
    cos = jnp.cos(ang).astype(t.dtype)
    sin = jnp.sin(ang).astype(t.dtype)
    t1, t2 = t[..., :half], t[..., half:]
    return jnp.concatenate([t1 * cos - t2 * sin, t1 * sin + t2 * cos], axis=-1)


def _retention(q, k, v):
    b, L, _ = q.shape
    pad = (-L) % CHUNK
    Lp = L + pad
    n = Lp // CHUNK

    def heads(t):
        t = t.reshape(b, L, RET_HEADS, RET_HEAD_DIM).transpose(0, 2, 1, 3)
        return jnp.pad(t, ((0, 0), (0, 0), (pad, 0), (0, 0)))

    q, k, v = heads(q), heads(k), heads(v)
    pos = jnp.arange(Lp, dtype=jnp.float32) - pad
    q = _rotary(q, pos) * (RET_HEAD_DIM ** -0.5)
    k = _rotary(k, pos)
    shp = (b, RET_HEADS, n, CHUNK, RET_HEAD_DIM)
    q, k, v = q.reshape(shp), k.reshape(shp), v.reshape(shp)

    dt = q.dtype
    log_gamma = jnp.log1p(-(2.0 ** (-5.0 - jnp.arange(RET_HEADS, dtype=jnp.float32))))
    idx = jnp.arange(CHUNK, dtype=jnp.float32)
    diff = idx[:, None] - idx[None, :]
    intra = jnp.where(diff[None] >= 0, jnp.exp(diff[None] * log_gamma[:, None, None]), 0.0)
    k_decay = jnp.exp((CHUNK - 1.0 - idx)[None, :] * log_gamma[:, None])
    q_decay = jnp.exp((idx + 1.0)[None, :] * log_gamma[:, None])
    chunk_decay = jnp.exp(CHUNK * log_gamma)

    scores = jnp.einsum('bhncd,bhnmd->bhncm', q, k) * intra[None, :, None].astype(dt)
    inner = jnp.einsum('bhncm,bhnmd->bhncd', scores, v)
    kv = jnp.einsum('bhncd,bhnce->nbhde', k * k_decay[None, :, None, :, None].astype(dt), v)
    cd = chunk_decay[None, :, None, None].astype(dt)

    def step(state, kv_n):
        return state * cd + kv_n, state

    s0 = jnp.zeros((b, RET_HEADS, RET_HEAD_DIM, RET_HEAD_DIM), dt)
    _, s_prev = lax.scan(step, s0, kv)
    cross = jnp.einsum('bhncd,nbhde->bhnce', q * q_decay[None, :, None, :, None].astype(dt), s_prev)
    out = (inner + cross).reshape(b, RET_HEADS, Lp, RET_HEAD_DIM)[:, :, pad:]

    of = out.astype(jnp.float32)
    mu = jnp.mean(of, axis=-1, keepdims=True)
    var = jnp.mean(jnp.square(of - mu), axis=-1, keepdims=True)
    of = (of - mu) * lax.rsqrt(var + EPS)
    return of.astype(dt).transpose(0, 2, 1, 3).reshape(b, L, RET_WIDTH)


def _pool_mixer(u, maps, scale):
    b, L, _ = u.shape
    uf = u.astype(jnp.float32)
    t = jnp.arange(L, dtype=jnp.float32)[None, :, None]
    outs = []
    for g, w in enumerate(POOL_WINDOWS):
        ug = uf[..., g * POOL_GROUP_DIM:(g + 1) * POOL_GROUP_DIM]
        cs = jnp.cumsum(ug, axis=1)
        lag = jnp.pad(cs, ((0, 0), (w, 0), (0, 0)))[:, :L]
        mean = (cs - lag) / jnp.minimum(t + 1.0, float(w))
        pooled = (mean - ug).astype(u.dtype)
        outs.append(pooled @ maps[g])
    return jnp.concatenate(outs, axis=-1) * scale


def setup_inputs(seed: int = 0) -> dict:
    key = jax.random.key(seed)
    ks = jax.random.split(key, 20)
    f32 = jnp.float32

    def w(k, shape, fan_in):
        return jax.random.normal(k, shape, f32) * (fan_in ** -0.5)

    def gain(k, shape):
        return 1.0 + 0.02 * jax.random.normal(k, shape, f32)

    return {
        'x': jax.random.normal(ks[0], (BATCH, SEQ, D_MODEL), f32),
        'meta': jax.random.normal(ks[1], (N_META, D_MODEL), f32),
        'ffn1_norm': gain(ks[2], (DEPTH, D_MODEL)),
        'ffn1_gate': w(ks[3], (DEPTH, D_MODEL, D_FF), D_MODEL),
        'ffn1_up': w(ks[4], (DEPTH, D_MODEL, D_FF), D_MODEL),
        'ffn1_down': w(ks[5], (DEPTH, D_FF, D_MODEL), D_FF),
        'mix_norm': gain(ks[6], (DEPTH, D_MODEL)),
        'w_in': w(ks[7], (DEPTH, D_MODEL, N_IN), D_MODEL),
        'pool_maps': w(ks[8], (DEPTH, POOL_GROUPS, POOL_GROUP_DIM, POOL_GROUP_DIM), POOL_GROUP_DIM),
        'pool_scale': gain(ks[9], (DEPTH, POOL_WIDTH)),
        'w_ret_up': w(ks[10], (DEPTH, RET_WIDTH, D_MODEL), RET_WIDTH),
        'w_pool_up': w(ks[11], (DEPTH, POOL_WIDTH, D_MODEL), POOL_WIDTH),
        'w_out': w(ks[12], (DEPTH, D_MODEL, D_MODEL), D_MODEL),
        'ffn2_norm': gain(ks[13], (DEPTH, D_MODEL)),
        'ffn2_gate': w(ks[14], (DEPTH, D_MODEL, D_FF), D_MODEL),
        'ffn2_up': w(ks[15], (DEPTH, D_MODEL, D_FF), D_MODEL),
        'ffn2_down': w(ks[16], (DEPTH, D_FF, D_MODEL), D_FF),
        'final_norm': gain(ks[17], (D_MODEL,)),
    }


def reference(x, meta, ffn1_norm, ffn1_gate, ffn1_up, ffn1_down, mix_norm, w_in,
              pool_maps, pool_scale, w_ret_up, w_pool_up, w_out,
              ffn2_norm, ffn2_gate, ffn2_up, ffn2_down, final_norm):
    b = x.shape[0]
    meta_b = jnp.broadcast_to(meta[None].astype(x.dtype), (b, N_META, D_MODEL))
    h = jnp.concatenate([meta_b, x], axis=1)
    splits = np.cumsum([RET_WIDTH, RET_WIDTH, RET_WIDTH, RET_WIDTH, POOL_WIDTH, D_MODEL])
    for i in range(DEPTH):
        h = h + 0.5 * _swiglu(_rmsnorm(h, ffn1_norm[i]), ffn1_gate[i], ffn1_up[i], ffn1_down[i])
        z = _rmsnorm(h, mix_norm[i]) @ w_in[i]
        q, k, v, g_ret, u_pool, gate_a, gate_b = jnp.split(z, splits, axis=-1)
        ret = (_retention(q, k, v) * jax.nn.silu(g_ret)) @ w_ret_up[i]
        pool = _pool_mixer(u_pool, pool_maps[i], pool_scale[i]) @ w_pool_up[i]
        mixed = jax.nn.sigmoid(gate_a) * ret + jax.nn.sigmoid(gate_b) * pool
        h = h + mixed @ w_out[i]
        h = h + 0.5 * _swiglu(_rmsnorm(h, ffn2_norm[i]), ffn2_gate[i], ffn2_up[i], ffn2_down[i])
    h = _rmsnorm(h, final_norm)
    return h[:, N_META:]
```

```cpp
#include <hip/hip_runtime.h>
#include <hip/hip_cooperative_groups.h>
#include <cstdio>
#include <cstdint>
namespace cg = cooperative_groups;

#ifndef PHMASK
#define PHMASK 0xffff
#endif
#ifndef MK_MULTI
#define MK_MULTI 0
#endif

#define LAS __attribute__((address_space(3)))
typedef unsigned short bf16_t;
typedef short bf16x8 __attribute__((ext_vector_type(8)));
typedef float f32x4 __attribute__((ext_vector_type(4)));
typedef unsigned u32x4 __attribute__((ext_vector_type(4)));
typedef unsigned u32x2 __attribute__((ext_vector_type(2)));
typedef unsigned long long u64;
__device__ __forceinline__ u64 f2rq(float s) { return (u64)(s * 4096.0f + 0.5f); }
__device__ __forceinline__ float rq2f(u64 q) { return (float)(unsigned)q * (1.0f / 4096.0f); }
__device__ __forceinline__ unsigned rq_lo(const u64* p, int idx) { return ((const unsigned*)p)[2 * idx]; }
__device__ __forceinline__ float rqlo2f(unsigned lo) { return (float)lo * (1.0f / 4096.0f); }

constexpr int DM = 1024, NBATCH = 8, SEQ = 4096, NMETA = 16, FF = 2816, NIN = 4608;
constexpr int TS = NBATCH * SEQ;
constexpr int TM = 33024;
constexpr int NPOS = SEQ + NMETA;
constexpr int NCH = 33;
constexpr int NPH = 21;
constexpr int LDS_BYTES = 131072 + 16;

constexpr size_t WS_ROWSQ = 0;
constexpr size_t WS_BAR   = 1900544;
constexpr size_t WS_CNT   = WS_BAR + 16384;
constexpr size_t WS_TAB   = 2u << 20;
constexpr size_t WS_HMETA = WS_TAB + (size_t)NPOS * 64 * 8 + 65536 - ((size_t)NPOS * 64 * 8) % 65536;
constexpr size_t WS_KV0   = WS_HMETA + 256 * 1024 * 4;
constexpr size_t WS_W     = WS_KV0 + 4 * 16384 * 4;
constexpr size_t W_W1 = 0, W_W1D = W_W1 + (size_t)2 * FF * DM * 2, W_WIN = W_W1D + (size_t)DM * FF * 2, W_WRP = W_WIN + (size_t)NIN * DM * 2,
                 W_WO = W_WRP + (size_t)DM * DM * 2, W_W2 = W_WO + (size_t)DM * DM * 2, W_W2D = W_W2 + (size_t)2 * FF * DM * 2, W_LAYER = W_W2D + (size_t)DM * FF * 2;
constexpr size_t WS_HB    = WS_W + 2 * W_LAYER;
constexpr size_t HB_BYTES = (size_t)NBATCH * 4 * NCH * 16384 * 4;
constexpr size_t WS_Z     = WS_HB + HB_BYTES;
constexpr size_t WS_G     = WS_Z + (size_t)TM * NIN * 2;
constexpr size_t WS_END   = WS_G + (size_t)NBATCH * 4 * 8 * 16384 * 2;

struct Params { const float* in[18]; float* out; unsigned char* ws; int ph_lo, ph_hi; };

__device__ __forceinline__ unsigned cvt_pk_bf16(float lo, float hi) { unsigned r; asm("v_cvt_pk_bf16_f32 %0, %1, %2" : "=v"(r) : "v"(lo), "v"(hi)); return r; }
__device__ __forceinline__ float bflo(unsigned w) { return __uint_as_float(w << 16); }
__device__ __forceinline__ float bfhi(unsigned w) { return __uint_as_float(w & 0xffff0000u); }
__device__ __forceinline__ float bf2f(bf16_t b) { return __uint_as_float(((unsigned)b) << 16); }
__device__ __forceinline__ float fast_rcp(float x) { return __builtin_amdgcn_rcpf(x); }
__device__ __forceinline__ float expneg(float x) { return __expf(-x); }
__device__ __forceinline__ float silu_f(float x) { return x * fast_rcp(1.0f + expneg(x)); }
__device__ __forceinline__ float wave_sum(float v) {
#pragma unroll
    for (int o = 1; o < 64; o <<= 1) v += __shfl_xor(v, o);
    return v;
}
__device__ __forceinline__ int zrow_of(int b, int p) { return p < NMETA ? TS + p : b * SEQ + (p - NMETA); }
__device__ __forceinline__ float log2_gamma(int head) { return log2f(1.0f - exp2f(-5.0f - (float)head)); }


#define XB_TMO      128
#define XB_XCNT(j)  (256  + 64 * (j))
#define XB_XSUB(j)  (1280 + 64 * (j))
#define XB_XGEN(j)  (2304 + 64 * (j))
#define XB_TOP      3328
#define XB_TOPGEN   3392
#define XCD_BAR_WORDS 3456
#define XB_SPIN_CAP (1u << 18)
__device__ __forceinline__ unsigned xb_ld(unsigned* p)              { return __hip_atomic_load(p, __ATOMIC_RELAXED, __HIP_MEMORY_SCOPE_AGENT); }
__device__ __forceinline__ unsigned xb_add(unsigned* p, unsigned v) { return __hip_atomic_fetch_add(p, v, __ATOMIC_RELAXED, __HIP_MEMORY_SCOPE_AGENT); }
__device__ __forceinline__ unsigned xb_xcc_id() { return (unsigned)__builtin_amdgcn_s_getreg((3 << 11) | 20) & 0xFu; }
#define XB_SPIN(cond, bar) do { unsigned _sp = 0; while (cond) { __builtin_amdgcn_s_sleep(1); \
    if ((++_sp & 255u) == 0u) { if (xb_ld(&(bar)[XB_TMO])) break; if (_sp > XB_SPIN_CAP) { atomicAdd(&(bar)[XB_TMO], 1u); break; } } } } while (0)
struct XcdBarrier { unsigned* bar; unsigned x; volatile LAS unsigned* st; };
__device__ __forceinline__ XcdBarrier xcd_barrier_post(unsigned* bar, volatile LAS unsigned* st) {
    XcdBarrier b; b.bar = bar; b.x = xb_xcc_id(); b.st = st;
    if (threadIdx.x == 0) (void)xb_add(&bar[XB_XCNT(b.x)], 1u);
    return b;
}
__device__ __forceinline__ void xcd_barrier_complete(unsigned* bar, unsigned x, unsigned& nloc, unsigned& nx) {
    const unsigned G = gridDim.x * gridDim.y * gridDim.z;
    unsigned sum, cnt, mine, sp = 0u;
    for (;;) {
        sum = 0u; cnt = 0u; mine = 0u;
#pragma unroll
        for (unsigned j = 0; j < 16; ++j) { const unsigned c = xb_ld(&bar[XB_XCNT(j)]); sum += c; cnt += (c > 0u) ? 1u : 0u; mine = (j == x) ? c : mine; }
        if (sum == G) break;
        __builtin_amdgcn_s_sleep(1);
        if ((++sp & 255u) == 0u) { if (xb_ld(&bar[XB_TMO])) break; if (sp > XB_SPIN_CAP) { atomicAdd(&bar[XB_TMO], 1u); break; } }
    }
    nloc = mine > 0u ? mine : 1u; nx = cnt > 0u ? cnt : 1u;
}
__device__ __forceinline__ void xcd_barrier(const XcdBarrier& b) {
    asm volatile("s_waitcnt vmcnt(0)" ::: "memory");
    __syncthreads();
    if (threadIdx.x == 0) {
        unsigned* bar = b.bar;
        __builtin_amdgcn_s_waitcnt(0);
        unsigned nloc = b.st[0], nx = b.st[1];
        if (nloc == 0u) { xcd_barrier_complete(bar, b.x, nloc, nx); b.st[0] = nloc; b.st[1] = nx; }
        const unsigned old = xb_add(&bar[XB_XSUB(b.x)], 1u);
        const unsigned gen = old / nloc;
        if (old + 1u == (gen + 1u) * nloc) {
            __builtin_amdgcn_fence(__ATOMIC_RELEASE, "agent");
            asm volatile("s_waitcnt vmcnt(0)" ::: "memory");
            const unsigned og = xb_add(&bar[XB_TOP], 1u);
            const unsigned tg = og / nx;
            if (og + 1u == (tg + 1u) * nx) xb_add(&bar[XB_TOPGEN], 1u);
            else XB_SPIN(xb_ld(&bar[XB_TOPGEN]) == tg, bar);
            __builtin_amdgcn_fence(__ATOMIC_ACQUIRE, "agent");
            xb_add(&bar[XB_XGEN(b.x)], 1u);
            asm volatile("s_waitcnt vmcnt(0)" ::: "memory");
        } else {
            XB_SPIN(xb_ld(&bar[XB_XGEN(b.x)]) == gen, bar);
            __builtin_amdgcn_fence(__ATOMIC_ACQUIRE, "agent");
            asm volatile("s_waitcnt vmcnt(0)" ::: "memory");
        }
    }
    __syncthreads();
}

namespace pg8 {
constexpr int BM = 256, BK = 64, HALF = 128, HTB = HALF * BK * 2, STAGE_BYTES = 8 * HTB, NXCD = 8, WGM = 8;
__host__ __device__ __forceinline__ int lds_byte(int r, int c) { const int st = (r >> 4) * 2 + (c >> 5), rr = r & 15, cc = c & 31, ob = rr * 64 + cc * 2; return st * 1024 + (ob ^ (((ob >> 9) & 1) << 5)); }
__host__ __device__ __forceinline__ void stage_rc(int b, int& R, int& C) { const int st = b / 1024, sb = b % 1024, swz = sb ^ (((sb >> 9) & 1) << 5); R = (st >> 1) * 16 + swz / 64; C = (st & 1) * 32 + (swz % 64) / 2; }
__host__ __device__ __forceinline__ int perm32(int rho) { const int n = rho >> 4, i = rho & 15; return 8 * (i >> 2) + 4 * n + (i & 3); }
struct Unit { int pm, pn; };
struct Gemm { const bf16_t* A; const bf16_t* Bt; int M, N, K, lda; };
struct StaticOrder {
    int nM, nN, nwg, G, c;
    __device__ void init(int M, int N, int G_, int c_) { nM = M / BM; nN = N / BM; nwg = nM * nN; G = G_; c = c_; }
    __device__ bool next(int i, Unit& u) const {
        const long L = (long)i * G + c; if (L >= nwg) return false;
        int wgid = (int)L; { const int q = nwg / NXCD, r = nwg % NXCD, xcd = wgid % NXCD, off = wgid / NXCD; wgid = (xcd < r ? xcd * (q + 1) : r * (q + 1) + (xcd - r) * q) + off; }
        const int nig = WGM * nN, gid = wgid / nig, fm = gid * WGM, gsz = (nM - fm) < WGM ? (nM - fm) : WGM;
        u.pm = fm + ((wgid % nig) % gsz); u.pn = (wgid % nig) / gsz; return true;
    }
};
template <class Epi>
__device__ __forceinline__ void gemm_phase(LAS unsigned char* lds, const Gemm g, const StaticOrder& S, const Epi& E) {
    int tid_ = threadIdx.x; asm volatile("" : "+v"(tid_));
    const int tid = tid_, wid = __builtin_amdgcn_readfirstlane(tid >> 6), lane = tid & 63, wr = wid >> 2, wc = wid & 3, fr = lane & 15, fq = lane >> 4;
    const int K = g.K, nt = K / BK, lda = g.lda;
    unsigned voffA[2], voffB[2];
#pragma unroll
    for (int i = 0; i < 2; ++i) { int R, C; stage_rc(tid * 16 + i * 8192, R, C); const int Rb = (R & ~31) + perm32(R & 31);
        voffA[i] = (unsigned)(R * lda + C) * 2u; voffB[i] = (unsigned)(Rb * K + C) * 2u; }
    const size_t kstep = (size_t)(BK * 2);
    const size_t hsA = (size_t)HALF * lda * 2, hsB = (size_t)HALF * K * 2;
    const size_t tsA = 2 * hsA, tsB = 2 * hsB;
    const unsigned ldsw = (unsigned)wid * 1024u;
    const int aoff = lds_byte(wr * 64 + fr, fq * 8), boff = lds_byte(wc * 32 + fr, fq * 8);
#define PG8_SA(b, h) (((b) * 2 + (h)) * HTB)
#define PG8_SB(b, h) ((4 + (b) * 2 + (h)) * HTB)
#define PG8_STAGE(bufoff, gbase, voff) do { _Pragma("unroll") for (int _i = 0; _i < 2; ++_i) \
        __builtin_amdgcn_global_load_lds((const unsigned*)((const char*)(gbase) + (voff)[_i]), (LAS unsigned*)(lds + (bufoff) + ldsw + _i * 8192), 16, 0, 0); } while (0)
#define PG8_LDA(dst, b, h) do { _Pragma("unroll") for (int m = 0; m < 4; ++m) _Pragma("unroll") for (int k = 0; k < 2; ++k) dst[m][k] = *(const LAS bf16x8*)(lds + PG8_SA(b, h) + aoff + m * 2048 + k * 1024); } while (0)
#define PG8_LDB(dst, b, h) do { _Pragma("unroll") for (int n = 0; n < 2; ++n) _Pragma("unroll") for (int k = 0; k < 2; ++k) dst[n][k] = *(const LAS bf16x8*)(lds + PG8_SB(b, h) + boff + n * 2048 + k * 1024); } while (0)
#define PG8_MMA(ai, bj, At, Bt) do { __builtin_amdgcn_s_setprio(1); _Pragma("unroll") for (int m = 0; m < 4; ++m) _Pragma("unroll") for (int n = 0; n < 2; ++n) _Pragma("unroll") for (int k = 0; k < 2; ++k) \
        acc[ai][bj][m][n] = __builtin_amdgcn_mfma_f32_16x16x32_bf16(Bt[n][k], At[m][k], acc[ai][bj][m][n], 0, 0, 0); __builtin_amdgcn_s_setprio(0); } while (0)
#define PG8_WAIT_V(n) asm volatile("s_waitcnt vmcnt(" #n ")" ::: "memory")
#define PG8_WAIT_L(n) asm volatile("s_waitcnt lgkmcnt(" #n ")" ::: "memory")
#define PG8_BAR __builtin_amdgcn_s_barrier()
#define PG8_SCHED __builtin_amdgcn_sched_barrier(0)
    Unit cur, nxt; int ui = 0;
    if (!S.next(0, cur)) return;
    f32x4 acc[2][2][4][2];
#pragma unroll
    for (int a = 0; a < 2; ++a)
#pragma unroll
        for (int b = 0; b < 2; ++b)
#pragma unroll
            for (int m = 0; m < 4; ++m)
#pragma unroll
                for (int n = 0; n < 2; ++n) acc[a][b][m][n] = (f32x4){0.f, 0.f, 0.f, 0.f};
    bf16x8 At[4][2], B0[2][2], B1[2][2];
    float pre[8];
#pragma unroll
    for (int i = 0; i < 8; ++i) pre[i] = 0.f;
    const char* cA = (const char*)g.A + (size_t)cur.pm * tsA; const char* cB = (const char*)g.Bt + (size_t)cur.pn * tsB;
    PG8_STAGE(PG8_SB(0, 0), cB, voffB); PG8_STAGE(PG8_SB(0, 1), cB + hsB, voffB); PG8_STAGE(PG8_SA(0, 0), cA, voffA); PG8_STAGE(PG8_SA(0, 1), cA + hsA, voffA);
    if (wr == 1) PG8_BAR;
    PG8_WAIT_V(2); PG8_BAR;
    PG8_STAGE(PG8_SB(1, 0), cB + kstep, voffB); PG8_STAGE(PG8_SA(1, 0), cA + kstep, voffA); PG8_STAGE(PG8_SB(1, 1), cB + hsB + kstep, voffB);
    PG8_WAIT_V(6); PG8_BAR;
    for (;;) {
        const bool has_next = S.next(ui + 1, nxt);
        const char* nA = has_next ? (const char*)g.A + (size_t)nxt.pm * tsA : cA; const char* nB = has_next ? (const char*)g.Bt + (size_t)nxt.pn * tsB : cB;
        for (int t = 0; t < nt; t += 2) {
            const bool last = (t == nt - 2);
            const char* a1 = cA + (size_t)(t + 1) * kstep;
            const char* a2 = last ? nA : cA + (size_t)(t + 2) * kstep; const char* b2 = last ? nB : cB + (size_t)(t + 2) * kstep;
            const char* a3 = a2 + kstep; const char* b3 = b2 + kstep;
            if constexpr (Epi::MID) { if (t == 8) E.mid(acc, cur, wr, wc, fr, fq); }
            if constexpr (Epi::PRE) { if (last) E.prefetch(pre, cur, wr, fr); }
            PG8_LDB(B0, 0, 0); PG8_LDB(B1, 0, 1); PG8_SCHED; PG8_LDA(At, 0, 0); PG8_STAGE(PG8_SA(1, 1), a1 + hsA, voffA);
            PG8_WAIT_V(8); PG8_WAIT_L(0); PG8_BAR; PG8_MMA(0, 0, At, B0); PG8_MMA(0, 1, At, B1); PG8_BAR; PG8_SCHED;
            PG8_LDA(At, 0, 1); PG8_STAGE(PG8_SB(0, 0), b2, voffB); PG8_STAGE(PG8_SB(0, 1), b2 + hsB, voffB); PG8_STAGE(PG8_SA(0, 0), a2, voffA);
            PG8_WAIT_V(8); PG8_WAIT_L(0); PG8_BAR; PG8_MMA(1, 0, At, B0); PG8_MMA(1, 1, At, B1); PG8_BAR; PG8_SCHED;
            PG8_LDB(B0, 1, 0); PG8_LDB(B1, 1, 1); PG8_SCHED; PG8_LDA(At, 1, 0); PG8_STAGE(PG8_SA(0, 1), a2 + hsA, voffA);
            PG8_WAIT_V(8); PG8_WAIT_L(0); PG8_BAR; PG8_MMA(0, 0, At, B0); PG8_MMA(0, 1, At, B1); PG8_BAR; PG8_SCHED;
            PG8_LDA(At, 1, 1); PG8_STAGE(PG8_SB(1, 0), b3, voffB); PG8_STAGE(PG8_SB(1, 1), b3 + hsB, voffB); PG8_STAGE(PG8_SA(1, 0), a3, voffA);
            PG8_WAIT_V(8); PG8_WAIT_L(0); PG8_BAR; PG8_MMA(1, 0, At, B0); PG8_MMA(1, 1, At, B1); PG8_BAR; PG8_SCHED;
        }
        if (wr == 0) PG8_BAR;
        E(acc, cur, wr, wc, fr, fq, pre);
        if (!has_next) break;
#pragma unroll
        for (int a = 0; a < 2; ++a)
#pragma unroll
            for (int b = 0; b < 2; ++b)
#pragma unroll
                for (int m = 0; m < 4; ++m)
#pragma unroll
                    for (int n = 0; n < 2; ++n) acc[a][b][m][n] = (f32x4){0.f, 0.f, 0.f, 0.f};
        cur = nxt; cA = nA; cB = nB; ++ui;
        if (wr == 1) PG8_BAR;
    }
    PG8_WAIT_V(0);
    PG8_BAR;
#undef PG8_SA
#undef PG8_SB
#undef PG8_STAGE
#undef PG8_LDA
#undef PG8_LDB
#undef PG8_MMA
#undef PG8_WAIT_V
#undef PG8_WAIT_L
#undef PG8_BAR
#undef PG8_SCHED
}
}
using pg8::Unit;
typedef const f32x4 (&AccRef)[2][2][4][2];

__device__ __forceinline__ u32x4 pack8(const f32x4 a, const f32x4 b) { u32x4 w; w.x = cvt_pk_bf16(a[0], a[1]); w.y = cvt_pk_bf16(a[2], a[3]); w.z = cvt_pk_bf16(b[0], b[1]); w.w = cvt_pk_bf16(b[2], b[3]); return w; }

struct EpiUp {
    static constexpr bool MID = false, PRE = true;
    const u64* rowsq; bf16_t* act;
    __device__ __forceinline__ void prefetch(float (&pre)[8], const Unit& u, int wr, int fr) const {
        const int row0 = u.pm * 256 + wr * 64 + fr;
#pragma unroll
        for (int i = 0; i < 8; ++i) pre[i] = __uint_as_float(rq_lo(rowsq, row0 + (i >> 2) * 128 + (i & 3) * 16));
    }
    __device__ __forceinline__ void operator()(AccRef acc, const Unit& u, int wr, int wc, int fr, int fq, const float (&pre)[8]) const {
        int row0 = u.pm * 256 + wr * 64 + fr; asm volatile("" : "+v"(row0)); const int col0 = u.pn * 128 + wc * 32 + 8 * fq;
#pragma unroll
        for (int ai = 0; ai < 2; ++ai)
#pragma unroll
            for (int m = 0; m < 4; ++m) { const int r = row0 + ai * 128 + m * 16; const float rs = rsqrtf(rqlo2f(__float_as_uint(pre[ai * 4 + m])) * (1.0f / DM) + 1e-6f);
                const float k1 = -1.4426950408889634f * rs, rs2 = rs * rs;
                f32x4 o0, o1;
#pragma unroll
                for (int i = 0; i < 4; ++i) {
                    const float g0 = acc[ai][0][m][0][i], g1 = acc[ai][0][m][1][i];
                    o0[i] = (g0 * acc[ai][1][m][0][i]) * (rs2 * fast_rcp(1.0f + __builtin_amdgcn_exp2f(g0 * k1)));
                    o1[i] = (g1 * acc[ai][1][m][1][i]) * (rs2 * fast_rcp(1.0f + __builtin_amdgcn_exp2f(g1 * k1))); }
                *(u32x4*)(act + (size_t)r * FF + col0) = pack8(o0, o1); asm volatile("" ::: "memory"); }
    }
};
template <bool B16, bool W32>
struct EpiDown {
    static constexpr bool MID = false, PRE = false;
    const float* base; float* out; bf16_t* hb; u64* rowsq_out; float scale;
    __device__ __forceinline__ void operator()(AccRef acc, const Unit& u, int wr, int wc, int fr, int fq, const float (&pre)[8]) const {
        int row0 = u.pm * 256 + wr * 64 + fr; asm volatile("" : "+v"(row0)); const int col0 = u.pn * 256 + wc * 32 + 8 * fq;
#pragma unroll
        for (int ai = 0; ai < 2; ++ai)
#pragma unroll
            for (int m = 0; m < 4; ++m) { const int r = row0 + ai * 128 + m * 16;
                float ss = 0.f;
#pragma unroll
                for (int bj = 0; bj < 2; ++bj) { const int c = col0 + bj * 128; bf16_t* hp = hb + (size_t)r * DM + c;
                    f32x4 b0, b1;
                    if constexpr (B16) { const u32x4 w = *(const u32x4*)hp; b0 = (f32x4){bflo(w.x), bfhi(w.x), bflo(w.y), bfhi(w.y)}; b1 = (f32x4){bflo(w.z), bfhi(w.z), bflo(w.w), bfhi(w.w)}; }
                    else { const float* bp = base + (size_t)r * DM + c; b0 = *(const f32x4*)bp; b1 = *(const f32x4*)(bp + 4); }
                    const f32x4 v0 = b0 + scale * acc[ai][bj][m][0], v1 = b1 + scale * acc[ai][bj][m][1];
                    if constexpr (W32) { float* op = out + (size_t)r * DM + c; *(f32x4*)op = v0; *(f32x4*)(op + 4) = v1; }
                    *(u32x4*)hp = pack8(v0, v1);
                    ss += (v0[0] * v0[0] + v0[1] * v0[1]) + (v0[2] * v0[2] + v0[3] * v0[3]) + (v1[0] * v1[0] + v1[1] * v1[1]) + (v1[2] * v1[2] + v1[3] * v1[3]); }
                ss += __shfl_xor(ss, 16); ss += __shfl_xor(ss, 32);
                if (fq == 0) atomicAdd(rowsq_out + r, f2rq(ss)); if (m == 3) asm volatile("" ::: "memory"); }
    }
};
struct EpiFinal {
    static constexpr bool MID = false, PRE = false;
    float* out; const bf16_t* hb; u64* rowsq; unsigned* cnt; const float* gfin;
    __device__ __forceinline__ void operator()(AccRef acc, const Unit& u, int wr, int wc, int fr, int fq, const float (&pre)[8]) const {
        int row0 = u.pm * 256 + wr * 64 + fr; asm volatile("" : "+v"(row0)); const int col0 = u.pn * 256 + wc * 32 + 8 * fq;
#pragma unroll
        for (int ai = 0; ai < 2; ++ai)
#pragma unroll
            for (int m = 0; m < 4; ++m) { const int r = row0 + ai * 128 + m * 16; float ss = 0.f;
#pragma unroll
                for (int bj = 0; bj < 2; ++bj) { const int c = col0 + bj * 128; const u32x4 w = *(const u32x4*)(hb + (size_t)r * DM + c);
                    const f32x4 v0 = (f32x4){bflo(w.x), bfhi(w.x), bflo(w.y), bfhi(w.y)} + 0.5f * acc[ai][bj][m][0], v1 = (f32x4){bflo(w.z), bfhi(w.z), bflo(w.w), bfhi(w.w)} + 0.5f * acc[ai][bj][m][1];
                    ss += (v0[0] * v0[0] + v0[1] * v0[1]) + (v0[2] * v0[2] + v0[3] * v0[3]) + (v1[0] * v1[0] + v1[1] * v1[1]) + (v1[2] * v1[2] + v1[3] * v1[3]); }
                ss += __shfl_xor(ss, 16); ss += __shfl_xor(ss, 32);
                if (fq == 0) atomicAdd(rowsq + r, f2rq(ss)); if (m & 1) asm volatile("" ::: "memory"); }
        asm volatile("s_waitcnt vmcnt(0)" ::: "memory");
        unsigned* cw = cnt + 64 * u.pm;
        if ((threadIdx.x & 63) == 0) __hip_atomic_fetch_add(cw, 1u, __ATOMIC_RELAXED, __HIP_MEMORY_SCOPE_AGENT);
        { unsigned sp = 0;
          while ((unsigned)__builtin_amdgcn_readfirstlane(__hip_atomic_load(cw, __ATOMIC_RELAXED, __HIP_MEMORY_SCOPE_AGENT)) < 32u) { __builtin_amdgcn_s_sleep(2); if (++sp > (1u << 22)) break; } }
        f32x4 gv[2][2];
#pragma unroll
        for (int bj = 0; bj < 2; ++bj) { gv[bj][0] = *(const f32x4*)(gfin + col0 + bj * 128); gv[bj][1] = *(const f32x4*)(gfin + col0 + bj * 128 + 4); }
#pragma unroll
        for (int ai = 0; ai < 2; ++ai)
#pragma unroll
            for (int m = 0; m < 4; ++m) { const int r = row0 + ai * 128 + m * 16; float* op = out + (size_t)r * DM;
                const float rs = rsqrtf(rq2f(__hip_atomic_load(rowsq + r, __ATOMIC_RELAXED, __HIP_MEMORY_SCOPE_AGENT)) * (1.0f / DM) + 1e-6f);
#pragma unroll
                for (int bj = 0; bj < 2; ++bj) { const int c = col0 + bj * 128; const u32x4 w = *(const u32x4*)(hb + (size_t)r * DM + c);
                    const f32x4 v0 = (f32x4){bflo(w.x), bfhi(w.x), bflo(w.y), bfhi(w.y)} + 0.5f * acc[ai][bj][m][0], v1 = (f32x4){bflo(w.z), bfhi(w.z), bflo(w.w), bfhi(w.w)} + 0.5f * acc[ai][bj][m][1];
                    *(f32x4*)(op + c) = v0 * rs * gv[bj][0]; *(f32x4*)(op + c + 4) = v1 * rs * gv[bj][1]; }
                asm volatile("" ::: "memory"); }
    }
};
struct EpiIn {
    static constexpr bool MID = false, PRE = false;
    const u64* rowsq; bf16_t* z; const float* tab;
    __device__ __forceinline__ void prefetch(float (&pre)[8], const Unit& u, int wr, int fr) const {
        const int row0 = u.pm * 256 + wr * 64 + fr;
#pragma unroll
        for (int i = 0; i < 8; ++i) pre[i] = __uint_as_float(rq_lo(rowsq, row0 + (i >> 2) * 128 + (i & 3) * 16));
    }
    __device__ __forceinline__ void operator()(AccRef acc, const Unit& u, int wr, int wc, int fr, int fq, const float (&pre)[8]) const {
        int row0 = u.pm * 256 + wr * 64 + fr; asm volatile("" : "+v"(row0));
        if (u.pn < 4) {
            const bool isq = u.pn < 2; const int hh = wc >> 1, head = (u.pn & 1) * 2 + hh, j0 = 32 * (wc & 1) + 8 * fq;
            const float lg = log2_gamma(head);
#pragma unroll
            for (int ai = 0; ai < 2; ++ai)
#pragma unroll
                for (int m = 0; m < 4; ++m) { const int r = row0 + ai * 128 + m * 16; const float rs = rsqrtf(rqlo2f(rq_lo(rowsq, r)) * (1.0f / DM) + 1e-6f);
                    const int sq = r & (SEQ - 1), pos = sq + NMETA, cidx = sq & 127;
                    const float f = rs * (isq ? 0.08838834764831845f * exp2f((float)cidx * lg) : exp2f(-(float)cidx * lg));
                    const f32x4* tp = (const f32x4*)(tab + ((size_t)pos * 64 + j0) * 2);
                    bf16_t* zp = z + (size_t)r * NIN + u.pn * 256 + hh * 128 + j0;
#pragma unroll
                    for (int n = 0; n < 2; ++n) { const f32x4 ta = tp[2 * n], tb = tp[2 * n + 1]; const f32x4 x1 = acc[ai][0][m][n], x2 = acc[ai][1][m][n];
                        u32x2 w1, w2;
                        w1.x = cvt_pk_bf16((x1[0] * ta[0] - x2[0] * ta[1]) * f, (x1[1] * ta[2] - x2[1] * ta[3]) * f); w1.y = cvt_pk_bf16((x1[2] * tb[0] - x2[2] * tb[1]) * f, (x1[3] * tb[2] - x2[3] * tb[3]) * f);
                        w2.x = cvt_pk_bf16((x1[0] * ta[1] + x2[0] * ta[0]) * f, (x1[1] * ta[3] + x2[1] * ta[2]) * f); w2.y = cvt_pk_bf16((x1[2] * tb[1] + x2[2] * tb[0]) * f, (x1[3] * tb[3] + x2[3] * tb[2]) * f);
                        *(u32x2*)(zp + 4 * n) = w1; *(u32x2*)(zp + 64 + 4 * n) = w2; }
                    asm volatile("" ::: "memory"); }
        } else {
            const int col0 = u.pn * 256 + wc * 32 + 8 * fq;
#pragma unroll
            for (int ai = 0; ai < 2; ++ai)
#pragma unroll
                for (int m = 0; m < 4; ++m) { const int r = row0 + ai * 128 + m * 16; const float rs = rsqrtf(rqlo2f(rq_lo(rowsq, r)) * (1.0f / DM) + 1e-6f);
#pragma unroll
                    for (int bj = 0; bj < 2; ++bj) *(u32x4*)(z + (size_t)r * NIN + col0 + bj * 128) = pack8(acc[ai][bj][m][0] * rs, acc[ai][bj][m][1] * rs);
                    if (m & 1) asm volatile("" ::: "memory"); }
        }
    }
};
struct EpiMix {
    static constexpr bool MID = true, PRE = false;
    bf16_t* z;
    static __device__ __forceinline__ float cl(float x) { return fminf(fmaxf(x, -30.f), 30.f); }
    __device__ __forceinline__ void mid(f32x4 (&acc)[2][2][4][2], const Unit& u, int wr, int wc, int fr, int fq) const {
        int row0 = u.pm * 256 + wr * 64 + fr; const int col0 = u.pn * 256 + wc * 32 + 8 * fq;
        asm volatile("" : "+v"(row0));
#pragma unroll
        for (int ai = 0; ai < 2; ++ai)
#pragma unroll
            for (int m = 0; m < 4; ++m) { const int r = row0 + ai * 128 + m * 16;
#pragma unroll
                for (int bj = 0; bj < 2; ++bj) { const bf16_t* gp = z + (size_t)r * NIN + 2560 + col0 + bj * 128;
                    const u32x4 ga = *(const u32x4*)gp, gb = *(const u32x4*)(gp + 1024);
#pragma unroll
                    for (int i = 0; i < 4; ++i) { const unsigned wa = ga[i], wb = gb[i];
                        const float r0 = (1.0f + expneg(cl(bflo(wb)))) * fast_rcp(1.0f + expneg(cl(bflo(wa))));
                        const float r1 = (1.0f + expneg(cl(bfhi(wb)))) * fast_rcp(1.0f + expneg(cl(bfhi(wa))));
                        acc[ai][bj][m][i >> 1][(i & 1) * 2] *= r0; acc[ai][bj][m][i >> 1][(i & 1) * 2 + 1] *= r1; } }
                if (m & 1) asm volatile("" ::: "memory"); }
    }
    __device__ __forceinline__ void operator()(AccRef acc, const Unit& u, int wr, int wc, int fr, int fq, const float (&pre)[8]) const {
        const int row0 = u.pm * 256 + wr * 64 + fr, col0 = u.pn * 256 + wc * 32 + 8 * fq;
#pragma unroll
        for (int ai = 0; ai < 2; ++ai)
#pragma unroll
            for (int m = 0; m < 4; ++m) { const int r = row0 + ai * 128 + m * 16;
#pragma unroll
                for (int bj = 0; bj < 2; ++bj) { const bf16_t* gp = z + (size_t)r * NIN + 3584 + col0 + bj * 128;
                    const u32x4 gb = *(const u32x4*)gp; f32x4 o0, o1;
                    o0[0] = acc[ai][bj][m][0][0] * fast_rcp(1.0f + expneg(cl(bflo(gb[0])))); o0[1] = acc[ai][bj][m][0][1] * fast_rcp(1.0f + expneg(cl(bfhi(gb[0]))));
                    o0[2] = acc[ai][bj][m][0][2] * fast_rcp(1.0f + expneg(cl(bflo(gb[1])))); o0[3] = acc[ai][bj][m][0][3] * fast_rcp(1.0f + expneg(cl(bfhi(gb[1]))));
                    o1[0] = acc[ai][bj][m][1][0] * fast_rcp(1.0f + expneg(cl(bflo(gb[2])))); o1[1] = acc[ai][bj][m][1][1] * fast_rcp(1.0f + expneg(cl(bfhi(gb[2]))));
                    o1[2] = acc[ai][bj][m][1][2] * fast_rcp(1.0f + expneg(cl(bflo(gb[3])))); o1[3] = acc[ai][bj][m][1][3] * fast_rcp(1.0f + expneg(cl(bfhi(gb[3]))));
                    *(u32x4*)(z + (size_t)r * NIN + 1024 + col0 + bj * 128) = pack8(o0, o1); }
                if (m & 1) asm volatile("" ::: "memory"); }
    }
};


struct SkArgs { const bf16_t* A; int lda; const bf16_t* Bt; int K; const u64* rowsq_in; u64* rowsq_out; float* hmeta; bf16_t* hb; bf16_t* z; const float* tab; float scale; };
template <int MODE>
__device__ __forceinline__ void skinny(LAS unsigned char* lds, const SkArgs a) {
    int tid_ = threadIdx.x; asm volatile("" : "+v"(tid_));
    const int tid = tid_, lane = tid & 63, wave = __builtin_amdgcn_readfirstlane(tid >> 6), l15 = lane & 15, g = lane >> 4;
    constexpr int NITEMS = MODE == 0 ? 176 : (MODE == 2 ? 256 : 64);
    const int K = a.K;
    LAS f32x4* red = (LAS f32x4*)lds;
    for (int it = blockIdx.x; it < NITEMS; it += gridDim.x) {
        int brow0 = 16 * it, brow1 = 0; bool pair = false;
        if (MODE == 0) { const int hid = 16 * it; brow0 = ((hid >> 7) << 8) + (hid & 127); brow1 = brow0 + 128; pair = true; }
        if (MODE == 2) { if (it < 32) { brow0 = ((it >> 3) << 8) + (((it >> 2) & 1) << 6) + 16 * (it & 3); brow1 = brow0 + 128; pair = true; } else brow0 = 1024 + 16 * (it - 32); }
        int kb, ke;
        if (MODE == 3) { kb = (wave >> 2) * 512 + (wave & 3) * 128; ke = kb + 128; } else { const int kper = K >> 3; kb = wave * kper; ke = kb + kper; }
        f32x4 acc0 = (f32x4){0.f, 0.f, 0.f, 0.f}, acc1 = (f32x4){0.f, 0.f, 0.f, 0.f};
        const bf16_t* ap = a.A + (size_t)l15 * a.lda + 8 * g;
        const bf16_t* bp0 = a.Bt + (size_t)(brow0 + l15) * K + 8 * g;
        const bf16_t* bp1 = a.Bt + (size_t)(brow1 + l15) * K + 8 * g;
#pragma unroll 4
        for (int k = kb; k < ke; k += 32) { const bf16x8 av = *(const bf16x8*)(ap + k);
            acc0 = __builtin_amdgcn_mfma_f32_16x16x32_bf16(av, *(const bf16x8*)(bp0 + k), acc0, 0, 0, 0);
            if (pair) acc1 = __builtin_amdgcn_mfma_f32_16x16x32_bf16(av, *(const bf16x8*)(bp1 + k), acc1, 0, 0, 0); }
        red[(wave * 2 + 0) * 64 + lane] = acc0; red[(wave * 2 + 1) * 64 + lane] = acc1;
        __syncthreads();
        if (wave == 0) {
            f32x4 v0 = (f32x4){0.f, 0.f, 0.f, 0.f}, v1 = (f32x4){0.f, 0.f, 0.f, 0.f};
            if (MODE == 3) { for (int w = 0; w < 4; ++w) { v0 += red[(w * 2) * 64 + lane]; v1 += red[((w + 4) * 2) * 64 + lane]; } }
            else { for (int w = 0; w < 8; ++w) { v0 += red[(w * 2) * 64 + lane]; v1 += red[(w * 2 + 1) * 64 + lane]; } }
#pragma unroll
            for (int r = 0; r < 4; ++r) { const int row = 4 * g + r; const size_t R = (size_t)(TS + row);
                if (MODE == 0) { const float rs = rsqrtf(rq2f(a.rowsq_in[TS + row]) * (1.0f / DM) + 1e-6f);
                    a.z[R * FF + 16 * it + l15] = (bf16_t)(cvt_pk_bf16(silu_f(v0[r] * rs) * (v1[r] * rs), 0.f) & 0xffffu); }
                if (MODE == 1) { const int col = 16 * it + l15; const float hn = a.hmeta[(size_t)row * DM + col] + a.scale * v0[r];
                    a.hmeta[(size_t)row * DM + col] = hn; a.hb[R * DM + col] = (bf16_t)(cvt_pk_bf16(hn, 0.f) & 0xffffu);
                    float ss = hn * hn; ss += __shfl_xor(ss, 1); ss += __shfl_xor(ss, 2); ss += __shfl_xor(ss, 4); ss += __shfl_xor(ss, 8);
                    if (l15 == 0) atomicAdd(a.rowsq_out + TS + row, f2rq(ss)); }
                if (MODE == 2) { const float rs = rsqrtf(rq2f(a.rowsq_in[TS + row]) * (1.0f / DM) + 1e-6f);
                    if (it < 32) { const int pn = it >> 3, hh = (it >> 2) & 1, j = 16 * (it & 3) + l15, head = (pn & 1) * 2 + hh; const float lg = log2_gamma(head); const float cidx = (float)(112 + row);
                        const float f = rs * (pn < 2 ? 0.08838834764831845f * exp2f(cidx * lg) : exp2f(-cidx * lg));
                        const float c = a.tab[((size_t)row * 64 + j) * 2], sn = a.tab[((size_t)row * 64 + j) * 2 + 1];
                        bf16_t* zp = a.z + R * NIN + pn * 256 + hh * 128 + j;
                        zp[0] = (bf16_t)(cvt_pk_bf16((v0[r] * c - v1[r] * sn) * f, 0.f) & 0xffffu); zp[64] = (bf16_t)(cvt_pk_bf16((v0[r] * sn + v1[r] * c) * f, 0.f) & 0xffffu); }
                    else a.z[R * NIN + brow0 + l15] = (bf16_t)(cvt_pk_bf16(v0[r] * rs, 0.f) & 0xffffu); }
                if (MODE == 3) { const int col = 16 * it + l15; const float ga = bf2f(a.z[R * NIN + 2560 + col]), gb = bf2f(a.z[R * NIN + 3584 + col]);
                    const float mx = v0[r] * fast_rcp(1.0f + expneg(ga)) + v1[r] * fast_rcp(1.0f + expneg(gb));
                    a.z[R * NIN + 1024 + col] = (bf16_t)(cvt_pk_bf16(mx, 0.f) & 0xffffu); } }
        }
        __syncthreads();
    }
}

__device__ __forceinline__ int maprow(int map, int n) {
    if (map == 1) return ((n >> 7) << 8) + (n & 127);
    if (map == 2) return ((n >> 7) << 8) + 128 + (n & 127);
    if (map == 3) { if (n >= 1024) return n; const int pn = n >> 8, hh = (n >> 7) & 1, half = (n >> 6) & 1, j = n & 63; return (pn << 8) + (half << 7) + (hh << 6) + j; }
    return n;
}
__device__ __forceinline__ void conv_item(const float* src, int N, const float* gain, bf16_t* dst, int ldd, int koff, int map, int item, LAS float* scr, int lane) {
    const int nblk = N / 32, kb = item / nblk, nb = item % nblk, k0 = 64 * kb, n0 = 32 * nb;
    { f32x4 v[8]; const int kr = lane >> 3, n4 = lane & 7;
#pragma unroll
      for (int i = 0; i < 8; ++i) v[i] = *(const f32x4*)(src + (size_t)(k0 + 8 * i + kr) * N + n0 + 4 * n4);
#pragma unroll
      for (int i = 0; i < 8; ++i) { const int kk = 8 * i + kr; const float gg = gain ? gain[k0 + kk] : 1.0f; LAS float* d = scr + kk * 33 + 4 * n4;
          d[0] = v[i][0] * gg; d[1] = v[i][1] * gg; d[2] = v[i][2] * gg; d[3] = v[i][3] * gg; } }
    asm volatile("s_waitcnt lgkmcnt(0)" ::: "memory");
    const int c = lane & 7;
#pragma unroll
    for (int j = 0; j < 4; ++j) { const int n = (lane >> 3) + 8 * j; const LAS float* s = scr + (8 * c) * 33 + n;
        u32x4 o; o.x = cvt_pk_bf16(s[0 * 33], s[1 * 33]); o.y = cvt_pk_bf16(s[2 * 33], s[3 * 33]); o.z = cvt_pk_bf16(s[4 * 33], s[5 * 33]); o.w = cvt_pk_bf16(s[6 * 33], s[7 * 33]);
        *(u32x4*)(dst + (size_t)maprow(map, n0 + n) * ldd + koff + k0 + 8 * c) = o; }
    asm volatile("s_waitcnt lgkmcnt(0)" ::: "memory");
}
__device__ __forceinline__ void weff_item(const float* maps, const float* scale, const float* wp, bf16_t* dst, int item, int lane) {
    const int ab = item >> 4, nb = item & 15, i0 = 16 * ab, g = i0 >> 7, a0 = i0 & 127, n = 64 * nb + lane;
    const float* mp = maps + ((size_t)g * 128 + a0) * 128; const float* sc = scale + g * 128; const float* wc = wp + (size_t)(g * 128) * DM + n;
    float s[16];
#pragma unroll
    for (int a = 0; a < 16; ++a) s[a] = 0.f;
    for (int j = 0; j < 128; j += 4) {
        const float w0 = sc[j] * wc[(size_t)j * DM], w1 = sc[j + 1] * wc[(size_t)(j + 1) * DM], w2 = sc[j + 2] * wc[(size_t)(j + 2) * DM], w3 = sc[j + 3] * wc[(size_t)(j + 3) * DM];
#pragma unroll
        for (int a = 0; a < 16; ++a) { const float* m = mp + a * 128 + j; s[a] += m[0] * w0 + m[1] * w1 + m[2] * w2 + m[3] * w3; }
    }
    u32x4 o0, o1;
    o0.x = cvt_pk_bf16(s[0], s[1]); o0.y = cvt_pk_bf16(s[2], s[3]); o0.z = cvt_pk_bf16(s[4], s[5]); o0.w = cvt_pk_bf16(s[6], s[7]);
    o1.x = cvt_pk_bf16(s[8], s[9]); o1.y = cvt_pk_bf16(s[10], s[11]); o1.z = cvt_pk_bf16(s[12], s[13]); o1.w = cvt_pk_bf16(s[14], s[15]);
    bf16_t* d = dst + (size_t)n * DM + 512 + i0;
    *(u32x4*)d = o0; *(u32x4*)(d + 8) = o1;
}
__device__ __forceinline__ void row_to_bf16(const float* xrow, bf16_t* hbrow, float* hmrow, u64* rsq, int lane, bool zero) {
    f32x4 v[4]; float s = 0.f;
#pragma unroll
    for (int j = 0; j < 4; ++j) { v[j] = zero ? (f32x4){0.f, 0.f, 0.f, 0.f} : ((const f32x4*)xrow)[lane + 64 * j]; s += (v[j][0] * v[j][0] + v[j][1] * v[j][1]) + (v[j][2] * v[j][2] + v[j][3] * v[j][3]); }
    s = wave_sum(s);
#pragma unroll
    for (int j = 0; j < 4; ++j) { u32x2 w; w.x = cvt_pk_bf16(v[j][0], v[j][1]); w.y = cvt_pk_bf16(v[j][2], v[j][3]); ((u32x2*)hbrow)[lane + 64 * j] = w; if (hmrow) ((f32x4*)hmrow)[lane + 64 * j] = v[j]; }
    if (lane == 0) *rsq = f2rq(s);
}
__device__ __forceinline__ void phase_prep(const Params& P, LAS unsigned char* lds) {
    int tid_ = threadIdx.x; asm volatile("" : "+v"(tid_));
    const int tid = tid_, lane = tid & 63, wave = tid >> 6;
    const int gw = blockIdx.x * 8 + wave, NGW = gridDim.x * 8;
    LAS float* scr = (LAS float*)(lds + wave * 8448);
    unsigned char* ws = P.ws;
    constexpr int I_G = 16 * 88, I_D = 44 * 32, I_IN = 16 * 144, I_R = 8 * 32, I_O = 16 * 32;
    constexpr int PER_LAYER = 6 * I_G + I_IN + I_R + I_O;
    static_assert(I_G == I_D, "item counts");
    constexpr int NITEMS = 1024 + 2 * PER_LAYER;
    for (int it = gw; it < NITEMS; it += NGW) {
        if (it < 1024) { const int l = it >> 9, r = it & 511;
            weff_item(P.in[8] + (size_t)l * 4 * 128 * 128, P.in[9] + (size_t)l * 512, P.in[11] + (size_t)l * 512 * DM, (bf16_t*)(ws + WS_W + l * W_LAYER + W_WRP), r, lane); continue; }
        int r = it - 1024; const int l = r / PER_LAYER; r -= l * PER_LAYER;
        unsigned char* wl = ws + WS_W + l * W_LAYER;
        const float* n1 = P.in[2] + (size_t)l * DM; const float* nm = P.in[6] + (size_t)l * DM; const float* n2 = P.in[13] + (size_t)l * DM;
        if (r < I_G) { conv_item(P.in[3] + (size_t)l * DM * FF, FF, n1, (bf16_t*)(wl + W_W1), DM, 0, 1, r, scr, lane); continue; } r -= I_G;
        if (r < I_G) { conv_item(P.in[4] + (size_t)l * DM * FF, FF, n1, (bf16_t*)(wl + W_W1), DM, 0, 2, r, scr, lane); continue; } r -= I_G;
        if (r < I_D) { conv_item(P.in[5] + (size_t)l * FF * DM, DM, nullptr, (bf16_t*)(wl + W_W1D), FF, 0, 0, r, scr, lane); continue; } r -= I_D;
        if (r < I_IN) { conv_item(P.in[7] + (size_t)l * DM * NIN, NIN, nm, (bf16_t*)(wl + W_WIN), DM, 0, 3, r, scr, lane); continue; } r -= I_IN;
        if (r < I_R) { conv_item(P.in[10] + (size_t)l * 512 * DM, DM, nullptr, (bf16_t*)(wl + W_WRP), DM, 0, 0, r, scr, lane); continue; } r -= I_R;
        if (r < I_O) { conv_item(P.in[12] + (size_t)l * DM * DM, DM, nullptr, (bf16_t*)(wl + W_WO), DM, 0, 0, r, scr, lane); continue; } r -= I_O;
        if (r < I_G) { conv_item(P.in[14] + (size_t)l * DM * FF, FF, n2, (bf16_t*)(wl + W_W2), DM, 0, 1, r, scr, lane); continue; } r -= I_G;
        if (r < I_G) { conv_item(P.in[15] + (size_t)l * DM * FF, FF, n2, (bf16_t*)(wl + W_W2), DM, 0, 2, r, scr, lane); continue; } r -= I_G;
        conv_item(P.in[16] + (size_t)l * FF * DM, DM, nullptr, (bf16_t*)(wl + W_W2D), FF, 0, 0, r, scr, lane);
    }
    u64* rowsq = (u64*)(ws + WS_ROWSQ); bf16_t* hb = (bf16_t*)(ws + WS_HB); float* hmeta = (float*)(ws + WS_HMETA);
    for (int m = 2 * gw; m < TS; m += 2 * NGW) {
        const int m2 = m + 1; const f32x4* xa = (const f32x4*)(P.in[0] + (size_t)m * DM); const f32x4* xb = (const f32x4*)(P.in[0] + (size_t)m2 * DM);
        f32x4 va[4], vb[4]; float sa = 0.f, sb = 0.f;
#pragma unroll
        for (int j = 0; j < 4; ++j) { va[j] = xa[lane + 64 * j]; vb[j] = xb[lane + 64 * j]; }
#pragma unroll
        for (int j = 0; j < 4; ++j) { sa += (va[j][0] * va[j][0] + va[j][1] * va[j][1]) + (va[j][2] * va[j][2] + va[j][3] * va[j][3]); sb += (vb[j][0] * vb[j][0] + vb[j][1] * vb[j][1]) + (vb[j][2] * vb[j][2] + vb[j][3] * vb[j][3]); }
        sa = wave_sum(sa); sb = wave_sum(sb);
#pragma unroll
        for (int j = 0; j < 4; ++j) { u32x2 wa, wb; wa.x = cvt_pk_bf16(va[j][0], va[j][1]); wa.y = cvt_pk_bf16(va[j][2], va[j][3]); wb.x = cvt_pk_bf16(vb[j][0], vb[j][1]); wb.y = cvt_pk_bf16(vb[j][2], vb[j][3]);
            ((u32x2*)(hb + (size_t)m * DM))[lane + 64 * j] = wa; ((u32x2*)(hb + (size_t)m2 * DM))[lane + 64 * j] = wb; }
        if (lane == 0) { rowsq[m] = f2rq(sa); rowsq[m2] = f2rq(sb); } }
    for (int m = gw; m < NMETA; m += NGW) row_to_bf16(P.in[1] + (size_t)m * DM, hb + (size_t)(TS + m) * DM, hmeta + (size_t)m * DM, rowsq + TS + m, lane, false);
    const int gt = blockIdx.x * 512 + tid, NGT = gridDim.x * 512;
    for (int i = gt; i < 6 * TM; i += NGT) rowsq[TM + i] = 0ull;
    { unsigned* cnt = (unsigned*)(ws + WS_CNT); for (int i = gt; i < 128 * 64; i += NGT) cnt[i] = 0u; }
    float* tab = (float*)(ws + WS_TAB);
    for (int i = gt; i < NPOS * 64; i += NGT) { const int pos = i >> 6, j = i & 63;
        const double inv = exp2(-(double)j * (13.287712379549449 / 64.0)); const double ang = (double)pos * inv;
        const double k = rint(ang * 0.15915494309189535); const float rr = (float)(ang - k * 6.283185307179586);
        tab[2 * i] = cosf(rr); tab[2 * i + 1] = sinf(rr); }
}

__device__ __forceinline__ unsigned offb(unsigned row, unsigned ch) { return 256u * row + 16u * (ch ^ (((row & 3) << 2) | ((row >> 2) & 3))); }
__device__ __forceinline__ unsigned row_addr16(unsigned lane, unsigned rb, unsigned s) { return offb((lane & 15) + 16 * rb, 4 * s + (lane >> 4)); }
__device__ __forceinline__ unsigned tr_addr16(unsigned lane, unsigned c, unsigned ks, unsigned t) { const unsigned g = lane >> 4, q = (lane & 15) >> 2, p = lane & 3; return offb(32 * ks + 8 * g + 4 * t + q, 2 * c + (p >> 1)) + 8 * (p & 1); }
__device__ __forceinline__ bf16x8 tr_frag(unsigned tile, unsigned lane, unsigned c, unsigned ks) {
    u32x2 r0, r1; const unsigned a0 = tile + tr_addr16(lane, c, ks, 0), a1 = tile + tr_addr16(lane, c, ks, 1);
    asm volatile("ds_read_b64_tr_b16 %0, %2\n\tds_read_b64_tr_b16 %1, %3\n\ts_waitcnt lgkmcnt(0)" : "=&v"(r0), "=&v"(r1) : "v"(a0), "v"(a1) : "memory");
    u32x4 w; w.x = r0.x; w.y = r0.y; w.z = r1.x; w.w = r1.y; return __builtin_bit_cast(bf16x8, w);
}
__device__ __forceinline__ void tr_frag8(unsigned tile, unsigned lane, unsigned ks, bf16x8 (&f)[8]) {
    u32x2 r[16]; unsigned a[16];
#pragma unroll
    for (int c = 0; c < 8; ++c) { a[2 * c] = tile + tr_addr16(lane, c, ks, 0); a[2 * c + 1] = tile + tr_addr16(lane, c, ks, 1); }
    asm volatile("ds_read_b64_tr_b16 %0, %16\n\tds_read_b64_tr_b16 %1, %17\n\tds_read_b64_tr_b16 %2, %18\n\tds_read_b64_tr_b16 %3, %19\n\t"
                 "ds_read_b64_tr_b16 %4, %20\n\tds_read_b64_tr_b16 %5, %21\n\tds_read_b64_tr_b16 %6, %22\n\tds_read_b64_tr_b16 %7, %23\n\t"
                 "ds_read_b64_tr_b16 %8, %24\n\tds_read_b64_tr_b16 %9, %25\n\tds_read_b64_tr_b16 %10, %26\n\tds_read_b64_tr_b16 %11, %27\n\t"
                 "ds_read_b64_tr_b16 %12, %28\n\tds_read_b64_tr_b16 %13, %29\n\tds_read_b64_tr_b16 %14, %30\n\tds_read_b64_tr_b16 %15, %31\n\ts_waitcnt lgkmcnt(0)"
                 : "=&v"(r[0]), "=&v"(r[1]), "=&v"(r[2]), "=&v"(r[3]), "=&v"(r[4]), "=&v"(r[5]), "=&v"(r[6]), "=&v"(r[7]),
                   "=&v"(r[8]), "=&v"(r[9]), "=&v"(r[10]), "=&v"(r[11]), "=&v"(r[12]), "=&v"(r[13]), "=&v"(r[14]), "=&v"(r[15])
                 : "v"(a[0]), "v"(a[1]), "v"(a[2]), "v"(a[3]), "v"(a[4]), "v"(a[5]), "v"(a[6]), "v"(a[7]),
                   "v"(a[8]), "v"(a[9]), "v"(a[10]), "v"(a[11]), "v"(a[12]), "v"(a[13]), "v"(a[14]), "v"(a[15]) : "memory");
#pragma unroll
    for (int c = 0; c < 8; ++c) { u32x4 w; w.x = r[2 * c].x; w.y = r[2 * c].y; w.z = r[2 * c + 1].x; w.w = r[2 * c + 1].y; f[c] = __builtin_bit_cast(bf16x8, w); }
}
__device__ __forceinline__ bf16x8 row_frag(LAS unsigned char* tile, unsigned lane, unsigned rb, unsigned s) { return *(const LAS bf16x8*)(tile + row_addr16(lane, rb, s)); }

__device__ __forceinline__ void stage_ztile(const bf16_t* z, int b, int n, int cb, LAS unsigned char* tile, int tid) {
#pragma unroll
    for (int pass = 0; pass < 4; ++pass) { const int idx = tid + 512 * pass, row = idx >> 4, ch = idx & 15, p = n * 128 + row - 112;
        u32x4 v = (u32x4){0u, 0u, 0u, 0u};
        if (p >= 0) v = *(const u32x4*)(z + (size_t)zrow_of(b, p) * NIN + cb + ch * 8);
        *(LAS u32x4*)(tile + offb(row, ch)) = v; }
}
template <bool META> __device__ __forceinline__ void phase_ret(const Params& P, LAS unsigned char* lds);
template <bool LOWREG>
__device__ __forceinline__ void kv_compute(unsigned lbase_k, unsigned lbase_v, bf16_t* dst, int h, int lane, int wave) {
    const float g127 = exp2f(127.0f * log2_gamma(h));
    if constexpr (!LOWREG) {
        f32x4 acc[8];
#pragma unroll
        for (int i = 0; i < 8; ++i) acc[i] = (f32x4){0.f, 0.f, 0.f, 0.f};
#pragma unroll 1
        for (int ks = 0; ks < 4; ++ks) { const bf16x8 a = tr_frag(lbase_k, lane, wave, ks); bf16x8 vf[8]; tr_frag8(lbase_v, lane, ks, vf);
#pragma unroll
            for (int eb = 0; eb < 8; ++eb) acc[eb] = __builtin_amdgcn_mfma_f32_16x16x32_bf16(a, vf[eb], acc[eb], 0, 0, 0); }
#pragma unroll
        for (int eb = 0; eb < 8; ++eb) { u32x2 w; w.x = cvt_pk_bf16(acc[eb][0] * g127, acc[eb][1] * g127); w.y = cvt_pk_bf16(acc[eb][2] * g127, acc[eb][3] * g127);
            *(u32x2*)(dst + (size_t)(16 * eb + (lane & 15)) * 128 + 16 * wave + 4 * (lane >> 4)) = w; }
    } else {
#pragma unroll 1
        for (int eb = 0; eb < 8; ++eb) { f32x4 acc = (f32x4){0.f, 0.f, 0.f, 0.f};
#pragma unroll 1
            for (int ks = 0; ks < 4; ++ks) acc = __builtin_amdgcn_mfma_f32_16x16x32_bf16(tr_frag(lbase_k, lane, wave, ks), tr_frag(lbase_v, lane, eb, ks), acc, 0, 0, 0);
            u32x2 w; w.x = cvt_pk_bf16(acc[0] * g127, acc[1] * g127); w.y = cvt_pk_bf16(acc[2] * g127, acc[3] * g127);
            *(u32x2*)(dst + (size_t)(16 * eb + (lane & 15)) * 128 + 16 * wave + 4 * (lane >> 4)) = w; }
    }
}
__device__ __forceinline__ void phase_kv(const Params& P, LAS unsigned char* lds) {
    int tid_ = threadIdx.x; asm volatile("" : "+v"(tid_));
    const int tid = tid_, lane = tid & 63, wave = __builtin_amdgcn_readfirstlane(tid >> 6);
    const bf16_t* z = (const bf16_t*)(P.ws + WS_Z); bf16_t* G = (bf16_t*)(P.ws + WS_G);
    const unsigned lbase = (unsigned)(uintptr_t)lds;
    for (int it = blockIdx.x; it < 224; it += gridDim.x) {
        const int grp = it % 7, h = (it / 7) & 3, b = it / 28;
        const float lg = log2_gamma(h), cd = exp2f(128.0f * lg), g127 = exp2f(127.0f * lg);
        f32x4 acc[8];
#pragma unroll
        for (int i = 0; i < 8; ++i) acc[i] = (f32x4){0.f, 0.f, 0.f, 0.f};
#pragma unroll 1
        for (int j = 0; j < 4; ++j) { const int n = 4 * grp + 1 + j;
            stage_ztile(z, b, n, 512 + h * 128, lds, tid);
            stage_ztile(z, b, n, 1024 + h * 128, lds + 32768, tid);
            __syncthreads();
#pragma unroll
            for (int i = 0; i < 8; ++i) acc[i] = acc[i] * cd;
#pragma unroll 1
            for (int ks = 0; ks < 4; ++ks) { const bf16x8 a = tr_frag(lbase, lane, wave, ks); bf16x8 vf[8]; tr_frag8(lbase + 32768, lane, ks, vf);
#pragma unroll
                for (int eb = 0; eb < 8; ++eb) acc[eb] = __builtin_amdgcn_mfma_f32_16x16x32_bf16(a, vf[eb], acc[eb], 0, 0, 0); }
            __syncthreads(); }
        bf16_t* dst = G + ((size_t)((b * 4 + h) * 8 + grp)) * 16384;
#pragma unroll
        for (int eb = 0; eb < 8; ++eb) { u32x2 w; w.x = cvt_pk_bf16(acc[eb][0] * g127, acc[eb][1] * g127); w.y = cvt_pk_bf16(acc[eb][2] * g127, acc[eb][3] * g127);
            *(u32x2*)(dst + (size_t)(16 * eb + (lane & 15)) * 128 + 16 * wave + 4 * (lane >> 4)) = w; }
    }
    phase_ret<true>(P, lds);
}
template <int W> __device__ __forceinline__ void pool_part(bf16_t* z, int b, int n, int h, int tid) {
    const int j = tid & 127, qd = tid >> 7, colu = 2048 + h * 128 + j;
    constexpr int SB = 8;
#pragma unroll 1
    for (int sb = 0; sb < 32 / SB; ++sb) {
        const int p0 = n * 128 - 112 + 32 * qd + SB * sb;
        float u[SB + W - 1];
#pragma unroll
        for (int i = 0; i < SB + W - 1; ++i) { const int p = p0 - (W - 1) + i; u[i] = p >= 0 ? bf2f(z[(size_t)zrow_of(b, p) * NIN + colu]) : 0.f; }
        float sum = 0.f;
#pragma unroll
        for (int i = 0; i < W - 1; ++i) sum += u[i];
        float o[SB];
#pragma unroll
        for (int t = 0; t < SB; ++t) { const int p = p0 + t; const float ut = u[t + W - 1]; sum += ut;
            const float mean = (p + 1 < W) ? sum / (float)(p + 1 > 0 ? p + 1 : 1) : sum * (1.0f / (float)W);
            o[t] = mean - ut; sum -= u[t]; }
#pragma unroll
        for (int t = 0; t < SB; ++t) { const int p = p0 + t; if (p >= 0) z[(size_t)zrow_of(b, p) * NIN + 512 + h * 128 + j] = (bf16_t)(cvt_pk_bf16(o[t], 0.f) & 0xffffu); }
    }
}
template <bool META> __device__ __forceinline__ void phase_ret(const Params& P, LAS unsigned char* lds) {
    int tid_ = threadIdx.x; asm volatile("" : "+v"(tid_));
    const int tid = tid_, lane = tid & 63, wave = __builtin_amdgcn_readfirstlane(tid >> 6), g = lane >> 4, l15 = lane & 15;
    bf16_t* z = (bf16_t*)(P.ws + WS_Z); const bf16_t* G = (const bf16_t*)(P.ws + WS_G);
    const unsigned lbase = (unsigned)(uintptr_t)lds;
    LAS unsigned char* tq = lds; LAS unsigned char* tk = lds + 32768; LAS unsigned char* tst = lds + 98304;
    const int it_first = META ? (int)blockIdx.x - ((int)gridDim.x - 4) + 1024 : (int)blockIdx.x, it_end = META ? ((int)blockIdx.x >= (int)gridDim.x - 4 ? it_first + 1 : 0) : 256;
    for (int it = it_first; it < it_end; it += gridDim.x) {
        int grp, h, b; if (!META) { grp = it & 7; h = (it >> 3) & 3; b = it >> 5; } else { grp = 0; b = 0; h = it - 1024; asm volatile("" : "+s"(grp), "+s"(b)); }
        const float lg = log2_gamma(h), cd = exp2f(128.0f * lg);
        {
          const float gam = exp2f(lg); const bf16_t* kv0 = (const bf16_t*)(P.ws + WS_KV0) + (size_t)h * 16384; const bf16_t* gb = G + ((size_t)((b * 4 + h) * 8)) * 16384;
#pragma unroll 1
          for (int pass = 0; pass < 4; ++pass) { const int idx = tid + 512 * pass, row = idx >> 4, ch = idx & 15;
              float a[8];
#pragma unroll
              for (int i = 0; i < 8; ++i) a[i] = 0.f;
              if (!META) {
                  u32x4 v[8];
                  v[0] = *(const u32x4*)(kv0 + row * 128 + ch * 8);
#pragma unroll
                  for (int gp = 0; gp < 7; ++gp) { v[gp + 1] = (u32x4){0u, 0u, 0u, 0u}; if (gp < grp) v[gp + 1] = *(const u32x4*)(gb + (size_t)gp * 16384 + row * 128 + ch * 8); }
#pragma unroll
                  for (int t = 0; t < 8; ++t) { const float w = (t <= grp) ? gam * exp2f(512.0f * lg * (float)(t == 0 ? grp : grp - t)) : 0.f;
#pragma unroll
                    for (int i = 0; i < 4; ++i) { a[2 * i] += w * bflo(v[t][i]); a[2 * i + 1] += w * bfhi(v[t][i]); } } }
              u32x4 o; o.x = cvt_pk_bf16(a[0], a[1]); o.y = cvt_pk_bf16(a[2], a[3]); o.z = cvt_pk_bf16(a[4], a[5]); o.w = cvt_pk_bf16(a[6], a[7]);
              *(LAS u32x4*)(tst + offb(row, ch)) = o; } }
#pragma unroll 1
        for (int j = 0; j < (META ? 1 : 4); ++j) {
        const int n = META ? 0 : 4 * grp + 1 + j;
        stage_ztile(z, b, n, h * 128, tq, tid);
        stage_ztile(z, b, n, 512 + h * 128, tk, tid);
        stage_ztile(z, b, n, 1024 + h * 128, lds + 65536, tid);
        __syncthreads();
        f32x4 acc2[8];
#pragma unroll
        for (int i = 0; i < 8; ++i) acc2[i] = (f32x4){0.f, 0.f, 0.f, 0.f};
        const bool upd = !META && (j < 3);
        if (upd) {
#pragma unroll 1
            for (int ks = 0; ks < 4; ++ks) { const bf16x8 a = tr_frag(lbase + 32768, lane, wave, ks); bf16x8 vf[8]; tr_frag8(lbase + 65536, lane, ks, vf);
#pragma unroll
                for (int eb = 0; eb < 8; ++eb) acc2[eb] = __builtin_amdgcn_mfma_f32_16x16x32_bf16(a, vf[eb], acc2[eb], 0, 0, 0); } }
        if constexpr (META) kv_compute<true>(lbase + 32768, lbase + 65536, (bf16_t*)(P.ws + WS_KV0) + (size_t)h * 16384, h, lane, wave);
        switch (h) { case 0: pool_part<2>(z, b, n, h, tid); break; case 1: pool_part<4>(z, b, n, h, tid); break; case 2: pool_part<8>(z, b, n, h, tid); break; default: pool_part<16>(z, b, n, h, tid); break; }
        f32x4 acc[8];
#pragma unroll
        for (int i = 0; i < 8; ++i) acc[i] = (f32x4){0.f, 0.f, 0.f, 0.f};
        {
        bf16x8 qc[4];
#pragma unroll
        for (int ks = 0; ks < 4; ++ks) qc[ks] = row_frag(tq, lane, wave, ks);
#pragma unroll
        for (int ks = 0; ks < 4; ++ks) {
#pragma unroll
            for (int eb = 0; eb < 8; ++eb) acc[eb] = __builtin_amdgcn_mfma_f32_16x16x32_bf16(qc[ks], row_frag(tst, lane, eb, ks), acc[eb], 0, 0, 0);
            __builtin_amdgcn_sched_barrier(0); }
        }
        if (upd) {
            __syncthreads();
#pragma unroll
            for (int eb = 0; eb < 8; ++eb) { LAS u32x2* tp = (LAS u32x2*)(tst + offb(16 * eb + l15, 2 * wave + (g >> 1)) + 8 * (g & 1)); const u32x2 o = *tp; u32x2 w;
                w.x = cvt_pk_bf16(cd * (bflo(o.x) + acc2[eb][0]), cd * (bfhi(o.x) + acc2[eb][1])); w.y = cvt_pk_bf16(cd * (bflo(o.y) + acc2[eb][2]), cd * (bfhi(o.y) + acc2[eb][3])); *tp = w; }
        }
        bf16x8 qf[4];
#pragma unroll
        for (int ks = 0; ks < 4; ++ks) qf[ks] = row_frag(tq, lane, wave, ks);
        u32x2 pk[8];
#pragma unroll
        for (int mb = 0; mb < 8; ++mb) { f32x4 s = (f32x4){0.f, 0.f, 0.f, 0.f};
            if (mb <= wave) {
#pragma unroll
            for (int ks = 0; ks < 4; ++ks) s = __builtin_amdgcn_mfma_f32_16x16x32_bf16(row_frag(tk, lane, mb, ks), qf[ks], s, 0, 0, 0); }
            const int c = 16 * wave + l15, m0 = 16 * mb + 4 * g;
#pragma unroll
            for (int r = 0; r < 4; ++r) if (m0 + r > c) s[r] = 0.f;
            pk[mb].x = cvt_pk_bf16(s[0], s[1]); pk[mb].y = cvt_pk_bf16(s[2], s[3]); __builtin_amdgcn_sched_barrier(0); }
        __syncthreads();
#pragma unroll
        for (int mb = 0; mb < 8; ++mb) *(LAS u32x2*)(tk + offb(16 * wave + l15, 2 * mb + (g >> 1)) + 8 * (g & 1)) = pk[mb];
#pragma unroll 1
        for (int ks = 0; ks < 4; ++ks) { if (2 * ks <= wave) {
            const bf16x8 pf = row_frag(tk, lane, wave, ks); bf16x8 vf[8]; tr_frag8(lbase + 65536, lane, ks, vf);
#pragma unroll
            for (int eb = 0; eb < 8; ++eb) acc[eb] = __builtin_amdgcn_mfma_f32_16x16x32_bf16(pf, vf[eb], acc[eb], 0, 0, 0); } }
#pragma unroll
        for (int r = 0; r < 4; ++r) { float s = 0.f;
#pragma unroll
            for (int eb = 0; eb < 8; ++eb) s += acc[eb][r];
            s += __shfl_xor(s, 1); s += __shfl_xor(s, 2); s += __shfl_xor(s, 4); s += __shfl_xor(s, 8);
            const float mu = s * (1.0f / 128.0f); float q = 0.f;
#pragma unroll
            for (int eb = 0; eb < 8; ++eb) { const float d = acc[eb][r] - mu; q += d * d; }
            q += __shfl_xor(q, 1); q += __shfl_xor(q, 2); q += __shfl_xor(q, 4); q += __shfl_xor(q, 8);
            const float rstd = rsqrtf(q * (1.0f / 128.0f) + 1e-6f);
            const int c = 16 * wave + 4 * g + r;
#pragma unroll
            for (int eb = 0; eb < 8; ++eb) { const int e = 16 * eb + l15;
                *(LAS bf16_t*)(tq + offb(c, e >> 3) + (e & 7) * 2) = (bf16_t)(cvt_pk_bf16((acc[eb][r] - mu) * rstd, 0.f) & 0xffffu); } }
#pragma unroll
        for (int i = 0; i < 4; ++i) { const int idx = lane + 64 * i, c = 16 * wave + (idx >> 4), ch = idx & 15, p = n * 128 + c - 112;
            if (p >= 0) { const size_t zr = (size_t)zrow_of(b, p) * NIN;
                const u32x4 y = *(const LAS u32x4*)(tq + offb(c, ch)); const u32x4 gg = *(const u32x4*)(z + zr + 1536 + h * 128 + ch * 8);
                u32x4 o;
#pragma unroll
                for (int k = 0; k < 4; ++k) o[k] = cvt_pk_bf16(bflo(y[k]) * silu_f(bflo(gg[k])), bfhi(y[k]) * silu_f(bfhi(gg[k])));
                *(u32x4*)(z + zr + h * 128 + ch * 8) = o; } }
        __syncthreads();
        }
    }
}
__device__ __forceinline__ void phase_final(const Params& P) {
    int tid_ = threadIdx.x; asm volatile("" : "+v"(tid_));
    const int tid = tid_, lane = tid & 63, wave = tid >> 6; const int gw = blockIdx.x * 8 + wave, NGW = gridDim.x * 8;
    const u64* rowsq = (const u64*)(P.ws + WS_ROWSQ) + (size_t)6 * TM; const f32x4* gn = (const f32x4*)P.in[17];
    f32x4 gv[4];
#pragma unroll
    for (int j = 0; j < 4; ++j) gv[j] = gn[lane + 64 * j];
    for (int m = gw; m < TS; m += NGW) { const float rs = rsqrtf(rq2f(rowsq[m]) * (1.0f / DM) + 1e-6f); f32x4* o = (f32x4*)(P.out + (size_t)m * DM);
#pragma unroll
        for (int j = 0; j < 4; ++j) o[lane + 64 * j] = o[lane + 64 * j] * rs * gv[j]; }
}

__global__ void __launch_bounds__(512, 2) mk_fwd(Params P) {
    extern __shared__ __attribute__((aligned(16))) unsigned char lds_raw[];
    LAS unsigned char* lds = (LAS unsigned char*)lds_raw;
    cg::grid_group grid = cg::this_grid();
    const int lo = P.ph_lo, hi = P.ph_hi;
    unsigned char* ws = P.ws;
    u64* rowsq = (u64*)(ws + WS_ROWSQ); float* hmeta = (float*)(ws + WS_HMETA); bf16_t* hb = (bf16_t*)(ws + WS_HB); bf16_t* z = (bf16_t*)(ws + WS_Z);
    const float* tab = (const float*)(ws + WS_TAB);
#define IN(k) (lo <= (k) && (k) < hi)
    { LAS unsigned* stw = (LAS unsigned*)(lds + 131072); if (threadIdx.x < 4) stw[threadIdx.x] = 0u; }
    __syncthreads();
    const XcdBarrier xbar = xcd_barrier_post((unsigned*)(ws + WS_BAR), (volatile LAS unsigned*)(lds + 131072));
    if (lo < 0) grid.sync();
#define SEAM(k) do { if ((k) + 1 < hi) xcd_barrier(xbar); } while (0)
    if (IN(0)) { if (PHMASK & 1) phase_prep(P, lds); SEAM(0); }
    for (int l = 0; l < 2; ++l) {
        const int pb = 1 + 10 * l; unsigned char* wl = ws + WS_W + l * W_LAYER;
        pg8::StaticOrder S;
        if (IN(pb + 0)) { pg8::Gemm g{hb, (const bf16_t*)(wl + W_W1), TS, 2 * FF, DM, DM}; S.init(TS, 2 * FF, gridDim.x, blockIdx.x);
            if (PHMASK & 256) skinny<0>(lds, SkArgs{hb + (size_t)TS * DM, DM, (const bf16_t*)(wl + W_W1), DM, rowsq + (size_t)(3 * l) * TM, nullptr, hmeta, hb, z, tab, 0.f});
            EpiUp E{rowsq + (size_t)(3 * l) * TM, z}; if (PHMASK & 2) pg8::gemm_phase(lds, g, S, E); SEAM(pb + 0); }
        if (IN(pb + 1)) { pg8::Gemm g{z, (const bf16_t*)(wl + W_W1D), TS, DM, FF, FF}; S.init(TS, DM, gridDim.x, blockIdx.x);
            if (PHMASK & 256) skinny<1>(lds, SkArgs{z + (size_t)TS * FF, FF, (const bf16_t*)(wl + W_W1D), FF, nullptr, rowsq + (size_t)(3 * l + 1) * TM, hmeta, hb, z, tab, 0.5f});
            EpiDown<false, false> E{l == 0 ? P.in[0] : P.out, nullptr, hb, rowsq + (size_t)(3 * l + 1) * TM, 0.5f}; if (PHMASK & 4) pg8::gemm_phase(lds, g, S, E); SEAM(pb + 1); }
        if (IN(pb + 2)) { pg8::Gemm g{hb, (const bf16_t*)(wl + W_WIN), TS, NIN, DM, DM}; S.init(TS, NIN, gridDim.x, blockIdx.x);
            if (PHMASK & 256) skinny<2>(lds, SkArgs{hb + (size_t)TS * DM, DM, (const bf16_t*)(wl + W_WIN), DM, rowsq + (size_t)(3 * l + 1) * TM, nullptr, hmeta, hb, z, tab, 0.f});
            EpiIn E{rowsq + (size_t)(3 * l + 1) * TM, z, tab}; if (PHMASK & 8) pg8::gemm_phase(lds, g, S, E); SEAM(pb + 2); }
        if (IN(pb + 3)) { if (PHMASK & 16) phase_kv(P, lds); SEAM(pb + 3); }
        if (IN(pb + 5)) { if (PHMASK & 64) phase_ret<false>(P, lds); SEAM(pb + 5); }
        if (IN(pb + 6)) { pg8::Gemm g{z, (const bf16_t*)(wl + W_WRP), TS, DM, DM, NIN}; S.init(TS, DM, gridDim.x, blockIdx.x);
            if (PHMASK & 256) skinny<3>(lds, SkArgs{z + (size_t)TS * NIN, NIN, (const bf16_t*)(wl + W_WRP), DM, nullptr, nullptr, hmeta, hb, z, tab, 0.f});
            EpiMix E{z}; if (PHMASK & 128) pg8::gemm_phase(lds, g, S, E); SEAM(pb + 6); }
        if (IN(pb + 7)) { pg8::Gemm g{z + 1024, (const bf16_t*)(wl + W_WO), TS, DM, DM, NIN}; S.init(TS, DM, gridDim.x, blockIdx.x);
            if (PHMASK & 256) skinny<1>(lds, SkArgs{z + (size_t)TS * NIN + 1024, NIN, (const bf16_t*)(wl + W_WO), DM, nullptr, rowsq + (size_t)(3 * l + 2) * TM, hmeta, hb, z, tab, 1.0f});
            EpiDown<true, false> E{nullptr, nullptr, hb, rowsq + (size_t)(3 * l + 2) * TM, 1.0f}; pg8::gemm_phase(lds, g, S, E); SEAM(pb + 7); }
        if (IN(pb + 8)) { pg8::Gemm g{hb, (const bf16_t*)(wl + W_W2), TS, 2 * FF, DM, DM}; S.init(TS, 2 * FF, gridDim.x, blockIdx.x);
            if (PHMASK & 256) skinny<0>(lds, SkArgs{hb + (size_t)TS * DM, DM, (const bf16_t*)(wl + W_W2), DM, rowsq + (size_t)(3 * l + 2) * TM, nullptr, hmeta, hb, z, tab, 0.f});
            EpiUp E{rowsq + (size_t)(3 * l + 2) * TM, z}; pg8::gemm_phase(lds, g, S, E); SEAM(pb + 8); }
        if (IN(pb + 9)) { pg8::Gemm g{z, (const bf16_t*)(wl + W_W2D), TS, DM, FF, FF}; S.init(TS, DM, gridDim.x, blockIdx.x);
            if (PHMASK & 256) skinny<1>(lds, SkArgs{z + (size_t)TS * FF, FF, (const bf16_t*)(wl + W_W2D), FF, nullptr, rowsq + (size_t)(3 * l + 3) * TM, hmeta, hb, z, tab, 0.5f});
            const bool fuse_final = (l == 1) && (gridDim.x == 256);
            if (fuse_final) { EpiFinal E{P.out, hb, rowsq + (size_t)6 * TM, (unsigned*)(ws + WS_CNT), P.in[17]}; pg8::gemm_phase(lds, g, S, E); }
            else { EpiDown<true, true> E{nullptr, P.out, hb, rowsq + (size_t)(3 * l + 3) * TM, 0.5f}; pg8::gemm_phase(lds, g, S, E); }
            if (l == 1 && !fuse_final) { xcd_barrier(xbar); phase_final(P); }
            SEAM(pb + 9); }
    }
#undef IN
#undef SEAM
}

extern "C" void kernel_launch(void* const* d_in, const int* in_sizes, int n_in, void* d_out, int out_size, void* d_ws, size_t ws_size, hipStream_t stream) {
    static int grid = 0;
    if (grid == 0) {
        if (n_in != 18 || in_sizes[0] != TS * DM || out_size != TS * DM || ws_size < WS_END) { fprintf(stderr, "kernel_launch: unexpected shapes (n_in %d, in0 %d, out %d, ws %zu < %zu)\n", n_in, n_in > 0 ? in_sizes[0] : -1, out_size, ws_size, (size_t)WS_END); grid = -1; return; }
        int dev = 0, cus = 0, per_cu = 0;
        hipGetDevice(&dev); hipDeviceGetAttribute(&cus, hipDeviceAttributeMultiprocessorCount, dev);
        if (hipFuncSetAttribute((const void*)mk_fwd, hipFuncAttributeMaxDynamicSharedMemorySize, LDS_BYTES) != hipSuccess) { fprintf(stderr, "kernel_launch: hipFuncSetAttribute failed\n"); grid = -1; return; }
        if (hipOccupancyMaxActiveBlocksPerMultiprocessor(&per_cu, (const void*)mk_fwd, 512, LDS_BYTES) != hipSuccess || per_cu < 1) { fprintf(stderr, "kernel_launch: occupancy query says %d blocks/CU\n", per_cu); per_cu = 1; }
        (void)hipGetLastError();
        grid = cus * per_cu;
    }
    if (grid < 0) return;
    Params p{};
    for (int i = 0; i < 18; ++i) p.in[i] = (const float*)d_in[i];
    p.out = (float*)d_out; p.ws = (unsigned char*)d_ws;
#if MK_MULTI
    for (int ph = 0; ph < NPH; ++ph) { p.ph_lo = ph; p.ph_hi = ph + 1; hipLaunchKernelGGL(mk_fwd, dim3(grid), dim3(512), LDS_BYTES, stream, p); }
#else
    p.ph_lo = 0; p.ph_hi = NPH;
    (void)hipMemsetAsync((unsigned char*)d_ws + WS_BAR, 0, XCD_BAR_WORDS * 4, stream);
    void* args[] = {&p};
    hipError_t e = hipLaunchCooperativeKernel((const void*)mk_fwd, dim3(grid), dim3(512), args, LDS_BYTES, stream);
    if (e != hipSuccess) fprintf(stderr, "cooperative launch failed: %s (grid %d)\n", hipGetErrorString(e), grid);
#endif
}
```

```cpp
#include <hip/hip_runtime.h>
#include <hip/hip_cooperative_groups.h>
#include <cstdio>
#include <cstdint>
namespace cg = cooperative_groups;

#ifndef PHMASK
#define PHMASK 0xffff
#endif
#ifndef MK_MULTI
#define MK_MULTI 0
#endif

#define LAS __attribute__((address_space(3)))
typedef unsigned short bf16_t;
typedef short bf16x8 __attribute__((ext_vector_type(8)));
typedef float f32x4 __attribute__((ext_vector_type(4)));
typedef unsigned u32x4 __attribute__((ext_vector_type(4)));
typedef unsigned u32x2 __attribute__((ext_vector_type(2)));
typedef unsigned long long u64;
__device__ __forceinline__ u64 f2rq(float s) { return (u64)(s * 4096.0f + 0.5f); }
__device__ __forceinline__ float rq2f(u64 q) { return (float)(unsigned)q * (1.0f / 4096.0f); }
__device__ __forceinline__ unsigned rq_lo(const u64* p, int idx) { return ((const unsigned*)p)[2 * idx]; }
__device__ __forceinline__ float rqlo2f(unsigned lo) { return (float)lo * (1.0f / 4096.0f); }

constexpr int DM = 1024, NBATCH = 8, SEQ = 4096, NMETA = 16, FF = 2816, NIN = 4608;
constexpr int TS = NBATCH * SEQ;
constexpr int TM = 33024;
constexpr int NPOS = SEQ + NMETA;
constexpr int NCH = 33;
constexpr int NPH = 21;
constexpr int LDS_BYTES = 131072 + 16;

constexpr size_t WS_ROWSQ = 0;
constexpr size_t WS_BAR   = 1900544;
constexpr size_t WS_CNT   = WS_BAR + 16384;
constexpr size_t WS_TAB   = 2u << 20;
constexpr size_t WS_HMETA = WS_TAB + (size_t)NPOS * 64 * 8 + 65536 - ((size_t)NPOS * 64 * 8) % 65536;
constexpr size_t WS_KV0   = WS_HMETA + 256 * 1024 * 4;
constexpr size_t WS_W     = WS_KV0 + 4 * 16384 * 4;
constexpr size_t W_W1 = 0, W_W1D = W_W1 + (size_t)2 * FF * DM * 2, W_WIN = W_W1D + (size_t)DM * FF * 2, W_WRP = W_WIN + (size_t)NIN * DM * 2,
                 W_WO = W_WRP + (size_t)DM * DM * 2, W_W2 = W_WO + (size_t)DM * DM * 2, W_W2D = W_W2 + (size_t)2 * FF * DM * 2, W_LAYER = W_W2D + (size_t)DM * FF * 2;
constexpr size_t WS_HB    = WS_W + 2 * W_LAYER;
constexpr size_t HB_BYTES = (size_t)NBATCH * 4 * NCH * 16384 * 4;
constexpr size_t WS_Z     = WS_HB + HB_BYTES;
constexpr size_t WS_G     = WS_Z + (size_t)TM * NIN * 2;
constexpr size_t WS_END   = WS_G + (size_t)NBATCH * 4 * 8 * 16384 * 2;

struct Params { const float* in[18]; float* out; unsigned char* ws; int ph_lo, ph_hi; };

__device__ __forceinline__ unsigned cvt_pk_bf16(float lo, float hi) { unsigned r; asm("v_cvt_pk_bf16_f32 %0, %1, %2" : "=v"(r) : "v"(lo), "v"(hi)); return r; }
__device__ __forceinline__ float bflo(unsigned w) { return __uint_as_float(w << 16); }
__device__ __forceinline__ float bfhi(unsigned w) { return __uint_as_float(w & 0xffff0000u); }
__device__ __forceinline__ float bf2f(bf16_t b) { return __uint_as_float(((unsigned)b) << 16); }
__device__ __forceinline__ float fast_rcp(float x) { return __builtin_amdgcn_rcpf(x); }
__device__ __forceinline__ float expneg(float x) { return __expf(-x); }
__device__ __forceinline__ float silu_f(float x) { return x * fast_rcp(1.0f + expneg(x)); }
__device__ __forceinline__ float wave_sum(float v) {
#pragma unroll
    for (int o = 1; o < 64; o <<= 1) v += __shfl_xor(v, o);
    return v;
}
__device__ __forceinline__ int zrow_of(int b, int p) { return p < NMETA ? TS + p : b * SEQ + (p - NMETA); }
__device__ __forceinline__ float log2_gamma(int head) { return log2f(1.0f - exp2f(-5.0f - (float)head)); }


#define XB_TMO      128
#define XB_XCNT(j)  (256  + 64 * (j))
#define XB_XSUB(j)  (1280 + 64 * (j))
#define XB_XGEN(j)  (2304 + 64 * (j))
#define XB_TOP      3328
#define XB_TOPGEN   3392
#define XCD_BAR_WORDS 3456
#define XB_SPIN_CAP (1u << 18)
__device__ __forceinline__ unsigned xb_ld(unsigned* p)              { return __hip_atomic_load(p, __ATOMIC_RELAXED, __HIP_MEMORY_SCOPE_AGENT); }
__device__ __forceinline__ unsigned xb_add(unsigned* p, unsigned v) { return __hip_atomic_fetch_add(p, v, __ATOMIC_RELAXED, __HIP_MEMORY_SCOPE_AGENT); }
__device__ __forceinline__ unsigned xb_xcc_id() { return (unsigned)__builtin_amdgcn_s_getreg((3 << 11) | 20) & 0xFu; }
#define XB_SPIN(cond, bar) do { unsigned _sp = 0; while (cond) { __builtin_amdgcn_s_sleep(1); \
    if ((++_sp & 255u) == 0u) { if (xb_ld(&(bar)[XB_TMO])) break; if (_sp > XB_SPIN_CAP) { atomicAdd(&(bar)[XB_TMO], 1u); break; } } } } while (0)
struct XcdBarrier { unsigned* bar; unsigned x; volatile LAS unsigned* st; };
__device__ __forceinline__ XcdBarrier xcd_barrier_post(unsigned* bar, volatile LAS unsigned* st) {
    XcdBarrier b; b.bar = bar; b.x = xb_xcc_id(); b.st = st;
    if (threadIdx.x == 0) (void)xb_add(&bar[XB_XCNT(b.x)], 1u);
    return b;
}
__device__ __forceinline__ void xcd_barrier_complete(unsigned* bar, unsigned x, unsigned& nloc, unsigned& nx) {
    const unsigned G = gridDim.x * gridDim.y * gridDim.z;
    unsigned sum, cnt, mine, sp = 0u;
    for (;;) {
        sum = 0u; cnt = 0u; mine = 0u;
#pragma unroll
        for (unsigned j = 0; j < 16; ++j) { const unsigned c = xb_ld(&bar[XB_XCNT(j)]); sum += c; cnt += (c > 0u) ? 1u : 0u; mine = (j == x) ? c : mine; }
        if (sum == G) break;
        __builtin_amdgcn_s_sleep(1);
        if ((++sp & 255u) == 0u) { if (xb_ld(&bar[XB_TMO])) break; if (sp > XB_SPIN_CAP) { atomicAdd(&bar[XB_TMO], 1u); break; } }
    }
    nloc = mine > 0u ? mine : 1u; nx = cnt > 0u ? cnt : 1u;
}
__device__ __forceinline__ void xcd_barrier(const XcdBarrier& b) {
    asm volatile("s_waitcnt vmcnt(0)" ::: "memory");
    __syncthreads();
    if (threadIdx.x == 0) {
        unsigned* bar = b.bar;
        __builtin_amdgcn_s_waitcnt(0);
        unsigned nloc = b.st[0], nx = b.st[1];
        if (nloc == 0u) { xcd_barrier_complete(bar, b.x, nloc, nx); b.st[0] = nloc; b.st[1] = nx; }
        const unsigned old = xb_add(&bar[XB_XSUB(b.x)], 1u);
        const unsigned gen = old / nloc;
        if (old + 1u == (gen + 1u) * nloc) {
            __builtin_amdgcn_fence(__ATOMIC_RELEASE, "agent");
            asm volatile("s_waitcnt vmcnt(0)" ::: "memory");
            const unsigned og = xb_add(&bar[XB_TOP], 1u);
            const unsigned tg = og / nx;
            if (og + 1u == (tg + 1u) * nx) xb_add(&bar[XB_TOPGEN], 1u);
            else XB_SPIN(xb_ld(&bar[XB_TOPGEN]) == tg, bar);
            __builtin_amdgcn_fence(__ATOMIC_ACQUIRE, "agent");
            xb_add(&bar[XB_XGEN(b.x)], 1u);
            asm volatile("s_waitcnt vmcnt(0)" ::: "memory");
        } else {
            XB_SPIN(xb_ld(&bar[XB_XGEN(b.x)]) == gen, bar);
            __builtin_amdgcn_fence(__ATOMIC_ACQUIRE, "agent");
            asm volatile("s_waitcnt vmcnt(0)" ::: "memory");
        }
    }
    __syncthreads();
}

namespace pg8 {
constexpr int BM = 256, BK = 64, HALF = 128, HTB = HALF * BK * 2, STAGE_BYTES = 8 * HTB, NXCD = 8, WGM = 8;
__host__ __device__ __forceinline__ int lds_byte(int r, int c) { const int st = (r >> 4) * 2 + (c >> 5), rr = r & 15, cc = c & 31, ob = rr * 64 + cc * 2; return st * 1024 + (ob ^ (((ob >> 9) & 1) << 5)); }
__host__ __device__ __forceinline__ void stage_rc(int b, int& R, int& C) { const int st = b / 1024, sb = b % 1024, swz = sb ^ (((sb >> 9) & 1) << 5); R = (st >> 1) * 16 + swz / 64; C = (st & 1) * 32 + (swz % 64) / 2; }
__host__ __device__ __forceinline__ int perm32(int rho) { const int n = rho >> 4, i = rho & 15; return 8 * (i >> 2) + 4 * n + (i & 3); }
struct Unit { int pm, pn; };
struct Gemm { const bf16_t* A; const bf16_t* Bt; int M, N, K, lda; };
struct StaticOrder {
    int nM, nN, nwg, G, c;
    __device__ void init(int M, int N, int G_, int c_) { nM = M / BM; nN = N / BM; nwg = nM * nN; G = G_; c = c_; }
    __device__ bool next(int i, Unit& u) const {
        const long L = (long)i * G + c; if (L >= nwg) return false;
        int wgid = (int)L; { const int q = nwg / NXCD, r = nwg % NXCD, xcd = wgid % NXCD, off = wgid / NXCD; wgid = (xcd < r ? xcd * (q + 1) : r * (q + 1) + (xcd - r) * q) + off; }
        const int nig = WGM * nN, gid = wgid / nig, fm = gid * WGM, gsz = (nM - fm) < WGM ? (nM - fm) : WGM;
        u.pm = fm + ((wgid % nig) % gsz); u.pn = (wgid % nig) / gsz; return true;
    }
};
template <class Epi>
__device__ __forceinline__ void gemm_phase(LAS unsigned char* lds, const Gemm g, const StaticOrder& S, const Epi& E) {
    int tid_ = threadIdx.x; asm volatile("" : "+v"(tid_));
    const int tid = tid_, wid = __builtin_amdgcn_readfirstlane(tid >> 6), lane = tid & 63, wr = wid >> 2, wc = wid & 3, fr = lane & 15, fq = lane >> 4;
    const int K = g.K, nt = K / BK, lda = g.lda;
    unsigned voffA[2], voffB[2];
#pragma unroll
    for (int i = 0; i < 2; ++i) { int R, C; stage_rc(tid * 16 + i * 8192, R, C); const int Rb = (R & ~31) + perm32(R & 31);
        voffA[i] = (unsigned)(R * lda + C) * 2u; voffB[i] = (unsigned)(Rb * K + C) * 2u; }
    const size_t kstep = (size_t)(BK * 2);
    const size_t hsA = (size_t)HALF * lda * 2, hsB = (size_t)HALF * K * 2;
    const size_t tsA = 2 * hsA, tsB = 2 * hsB;
    const unsigned ldsw = (unsigned)wid * 1024u;
    const int aoff = lds_byte(wr * 64 + fr, fq * 8), boff = lds_byte(wc * 32 + fr, fq * 8);
#define PG8_SA(b, h) (((b) * 2 + (h)) * HTB)
#define PG8_SB(b, h) ((4 + (b) * 2 + (h)) * HTB)
#define PG8_STAGE(bufoff, gbase, voff) do { _Pragma("unroll") for (int _i = 0; _i < 2; ++_i) \
        __builtin_amdgcn_global_load_lds((const unsigned*)((const char*)(gbase) + (voff)[_i]), (LAS unsigned*)(lds + (bufoff) + ldsw + _i * 8192), 16, 0, 0); } while (0)
#define PG8_LDA(dst, b, h) do { _Pragma("unroll") for (int m = 0; m < 4; ++m) _Pragma("unroll") for (int k = 0; k < 2; ++k) dst[m][k] = *(const LAS bf16x8*)(lds + PG8_SA(b, h) + aoff + m * 2048 + k * 1024); } while (0)
#define PG8_LDB(dst, b, h) do { _Pragma("unroll") for (int n = 0; n < 2; ++n) _Pragma("unroll") for (int k = 0; k < 2; ++k) dst[n][k] = *(const LAS bf16x8*)(lds + PG8_SB(b, h) + boff + n * 2048 + k * 1024); } while (0)
#define PG8_MMA(ai, bj, At, Bt) do { __builtin_amdgcn_s_setprio(1); _Pragma("unroll") for (int m = 0; m < 4; ++m) _Pragma("unroll") for (int n = 0; n < 2; ++n) _Pragma("unroll") for (int k = 0; k < 2; ++k) \
        acc[ai][bj][m][n] = __builtin_amdgcn_mfma_f32_16x16x32_bf16(Bt[n][k], At[m][k], acc[ai][bj][m][n], 0, 0, 0); __builtin_amdgcn_s_setprio(0); } while (0)
#define PG8_WAIT_V(n) asm volatile("s_waitcnt vmcnt(" #n ")" ::: "memory")
#define PG8_WAIT_L(n) asm volatile("s_waitcnt lgkmcnt(" #n ")" ::: "memory")
#define PG8_BAR __builtin_amdgcn_s_barrier()
#define PG8_SCHED __builtin_amdgcn_sched_barrier(0)
    Unit cur, nxt; int ui = 0;
    if (!S.next(0, cur)) return;
    f32x4 acc[2][2][4][2];
#pragma unroll
    for (int a = 0; a < 2; ++a)
#pragma unroll
        for (int b = 0; b < 2; ++b)
#pragma unroll
            for (int m = 0; m < 4; ++m)
#pragma unroll
                for (int n = 0; n < 2; ++n) acc[a][b][m][n] = (f32x4){0.f, 0.f, 0.f, 0.f};
    bf16x8 At[4][2], B0[2][2], B1[2][2];
    float pre[8];
#pragma unroll
    for (int i = 0; i < 8; ++i) pre[i] = 0.f;
    const char* cA = (const char*)g.A + (size_t)cur.pm * tsA; const char* cB = (const char*)g.Bt + (size_t)cur.pn * tsB;
    PG8_STAGE(PG8_SB(0, 0), cB, voffB); PG8_STAGE(PG8_SB(0, 1), cB + hsB, voffB); PG8_STAGE(PG8_SA(0, 0), cA, voffA); PG8_STAGE(PG8_SA(0, 1), cA + hsA, voffA);
    if (wr == 1) PG8_BAR;
    PG8_WAIT_V(2); PG8_BAR;
    PG8_STAGE(PG8_SB(1, 0), cB + kstep, voffB); PG8_STAGE(PG8_SA(1, 0), cA + kstep, voffA); PG8_STAGE(PG8_SB(1, 1), cB + hsB + kstep, voffB);
    PG8_WAIT_V(6); PG8_BAR;
    for (;;) {
        const bool has_next = S.next(ui + 1, nxt);
        const char* nA = has_next ? (const char*)g.A + (size_t)nxt.pm * tsA : cA; const char* nB = has_next ? (const char*)g.Bt + (size_t)nxt.pn * tsB : cB;
        for (int t = 0; t < nt; t += 2) {
            const bool last = (t == nt - 2);
            const char* a1 = cA + (size_t)(t + 1) * kstep;
            const char* a2 = last ? nA : cA + (size_t)(t + 2) * kstep; const char* b2 = last ? nB : cB + (size_t)(t + 2) * kstep;
            const char* a3 = a2 + kstep; const char* b3 = b2 + kstep;
            if constexpr (Epi::MID) { if (t == 8) E.mid(acc, cur, wr, wc, fr, fq); }
            if constexpr (Epi::PRE) { if (last) E.prefetch(pre, cur, wr, fr); }
            PG8_LDB(B0, 0, 0); PG8_LDB(B1, 0, 1); PG8_SCHED; PG8_LDA(At, 0, 0); PG8_STAGE(PG8_SA(1, 1), a1 + hsA, voffA);
            PG8_WAIT_V(8); PG8_WAIT_L(0); PG8_BAR; PG8_MMA(0, 0, At, B0); PG8_MMA(0, 1, At, B1); PG8_BAR; PG8_SCHED;
            PG8_LDA(At, 0, 1); PG8_STAGE(PG8_SB(0, 0), b2, voffB); PG8_STAGE(PG8_SB(0, 1), b2 + hsB, voffB); PG8_STAGE(PG8_SA(0, 0), a2, voffA);
            PG8_WAIT_V(8); PG8_WAIT_L(0); PG8_BAR; PG8_MMA(1, 0, At, B0); PG8_MMA(1, 1, At, B1); PG8_BAR; PG8_SCHED;
            PG8_LDB(B0, 1, 0); PG8_LDB(B1, 1, 1); PG8_SCHED; PG8_LDA(At, 1, 0); PG8_STAGE(PG8_SA(0, 1), a2 + hsA, voffA);
            PG8_WAIT_V(8); PG8_WAIT_L(0); PG8_BAR; PG8_MMA(0, 0, At, B0); PG8_MMA(0, 1, At, B1); PG8_BAR; PG8_SCHED;
            PG8_LDA(At, 1, 1); PG8_STAGE(PG8_SB(1, 0), b3, voffB); PG8_STAGE(PG8_SB(1, 1), b3 + hsB, voffB); PG8_STAGE(PG8_SA(1, 0), a3, voffA);
            PG8_WAIT_V(8); PG8_WAIT_L(0); PG8_BAR; PG8_MMA(1, 0, At, B0); PG8_MMA(1, 1, At, B1); PG8_BAR; PG8_SCHED;
        }
        if (wr == 0) PG8_BAR;
        E(acc, cur, wr, wc, fr, fq, pre);
        if (!has_next) break;
#pragma unroll
        for (int a = 0; a < 2; ++a)
#pragma unroll
            for (int b = 0; b < 2; ++b)
#pragma unroll
                for (int m = 0; m < 4; ++m)
#pragma unroll
                    for (int n = 0; n < 2; ++n) acc[a][b][m][n] = (f32x4){0.f, 0.f, 0.f, 0.f};
        cur = nxt; cA = nA; cB = nB; ++ui;
        if (wr == 1) PG8_BAR;
    }
    PG8_WAIT_V(0);
    PG8_BAR;
#undef PG8_SA
#undef PG8_SB
#undef PG8_STAGE
#undef PG8_LDA
#undef PG8_LDB
#undef PG8_MMA
#undef PG8_WAIT_V
#undef PG8_WAIT_L
#undef PG8_BAR
#undef PG8_SCHED
}
}
using pg8::Unit;
typedef const f32x4 (&AccRef)[2][2][4][2];

__device__ __forceinline__ u32x4 pack8(const f32x4 a, const f32x4 b) { u32x4 w; w.x = cvt_pk_bf16(a[0], a[1]); w.y = cvt_pk_bf16(a[2], a[3]); w.z = cvt_pk_bf16(b[0], b[1]); w.w = cvt_pk_bf16(b[2], b[3]); return w; }

struct EpiUp {
    static constexpr bool MID = false, PRE = true;
    const u64* rowsq; bf16_t* act;
    __device__ __forceinline__ void prefetch(float (&pre)[8], const Unit& u, int wr, int fr) const {
        const int row0 = u.pm * 256 + wr * 64 + fr;
#pragma unroll
        for (int i = 0; i < 8; ++i) pre[i] = __uint_as_float(rq_lo(rowsq, row0 + (i >> 2) * 128 + (i & 3) * 16));
    }
    __device__ __forceinline__ void operator()(AccRef acc, const Unit& u, int wr, int wc, int fr, int fq, const float (&pre)[8]) const {
        int row0 = u.pm * 256 + wr * 64 + fr; asm volatile("" : "+v"(row0)); const int col0 = u.pn * 128 + wc * 32 + 8 * fq;
#pragma unroll
        for (int ai = 0; ai < 2; ++ai)
#pragma unroll
            for (int m = 0; m < 4; ++m) { const int r = row0 + ai * 128 + m * 16; const float rs = rsqrtf(rqlo2f(__float_as_uint(pre[ai * 4 + m])) * (1.0f / DM) + 1e-6f);
                const float k1 = -1.4426950408889634f * rs, rs2 = rs * rs;
                f32x4 o0, o1;
#pragma unroll
                for (int i = 0; i < 4; ++i) {
                    const float g0 = acc[ai][0][m][0][i], g1 = acc[ai][0][m][1][i];
                    o0[i] = (g0 * acc[ai][1][m][0][i]) * (rs2 * fast_rcp(1.0f + __builtin_amdgcn_exp2f(g0 * k1)));
                    o1[i] = (g1 * acc[ai][1][m][1][i]) * (rs2 * fast_rcp(1.0f + __builtin_amdgcn_exp2f(g1 * k1))); }
                *(u32x4*)(act + (size_t)r * FF + col0) = pack8(o0, o1); asm volatile("" ::: "memory"); }
    }
};
template <bool B16, bool W32>
struct EpiDown {
    static constexpr bool MID = false, PRE = false;
    const float* base; float* out; bf16_t* hb; u64* rowsq_out; float scale;
    __device__ __forceinline__ void operator()(AccRef acc, const Unit& u, int wr, int wc, int fr, int fq, const float (&pre)[8]) const {
        int row0 = u.pm * 256 + wr * 64 + fr; asm volatile("" : "+v"(row0)); const int col0 = u.pn * 256 + wc * 32 + 8 * fq;
#pragma unroll
        for (int ai = 0; ai < 2; ++ai)
#pragma unroll
            for (int mp = 0; mp < 2; ++mp) {
                f32x4 b[2][2][2];
#pragma unroll
                for (int q = 0; q < 2; ++q) { const int r = row0 + ai * 128 + (2 * mp + q) * 16;
#pragma unroll
                    for (int bj = 0; bj < 2; ++bj) { const int c = col0 + bj * 128;
                        if constexpr (B16) { const u32x4 w = *(const u32x4*)(hb + (size_t)r * DM + c); b[q][bj][0] = (f32x4){bflo(w.x), bfhi(w.x), bflo(w.y), bfhi(w.y)}; b[q][bj][1] = (f32x4){bflo(w.z), bfhi(w.z), bflo(w.w), bfhi(w.w)}; }
                        else { const float* bp = base + (size_t)r * DM + c; b[q][bj][0] = *(const f32x4*)bp; b[q][bj][1] = *(const f32x4*)(bp + 4); } } }
#pragma unroll
                for (int q = 0; q < 2; ++q) { const int m = 2 * mp + q, r = row0 + ai * 128 + m * 16; float ss = 0.f;
#pragma unroll
                    for (int bj = 0; bj < 2; ++bj) { const int c = col0 + bj * 128;
                        const f32x4 v0 = b[q][bj][0] + scale * acc[ai][bj][m][0], v1 = b[q][bj][1] + scale * acc[ai][bj][m][1];
                        if constexpr (W32) { float* op = out + (size_t)r * DM + c; *(f32x4*)op = v0; *(f32x4*)(op + 4) = v1; }
                        *(u32x4*)(hb + (size_t)r * DM + c) = pack8(v0, v1);
                        ss += (v0[0] * v0[0] + v0[1] * v0[1]) + (v0[2] * v0[2] + v0[3] * v0[3]) + (v1[0] * v1[0] + v1[1] * v1[1]) + (v1[2] * v1[2] + v1[3] * v1[3]); }
                    ss += __shfl_xor(ss, 16); ss += __shfl_xor(ss, 32);
                    if (fq == 0) atomicAdd(rowsq_out + r, f2rq(ss)); }
                asm volatile("" ::: "memory"); }
    }
};
struct EpiFinal {
    static constexpr bool MID = false, PRE = false;
    float* out; const bf16_t* hb; u64* rowsq; unsigned* cnt; const float* gfin;
    __device__ __forceinline__ void operator()(AccRef acc, const Unit& u, int wr, int wc, int fr, int fq, const float (&pre)[8]) const {
        int row0 = u.pm * 256 + wr * 64 + fr; asm volatile("" : "+v"(row0)); const int col0 = u.pn * 256 + wc * 32 + 8 * fq;
#pragma unroll
        for (int ai = 0; ai < 2; ++ai)
#pragma unroll
            for (int mp = 0; mp < 2; ++mp) {
                u32x4 w[2][2];
#pragma unroll
                for (int q = 0; q < 2; ++q)
#pragma unroll
                    for (int bj = 0; bj < 2; ++bj) w[q][bj] = *(const u32x4*)(hb + (size_t)(row0 + ai * 128 + (2 * mp + q) * 16) * DM + col0 + bj * 128);
#pragma unroll
                for (int q = 0; q < 2; ++q) { const int m = 2 * mp + q, r = row0 + ai * 128 + m * 16; float ss = 0.f;
#pragma unroll
                    for (int bj = 0; bj < 2; ++bj) { const u32x4 x = w[q][bj];
                        const f32x4 v0 = (f32x4){bflo(x.x), bfhi(x.x), bflo(x.y), bfhi(x.y)} + 0.5f * acc[ai][bj][m][0], v1 = (f32x4){bflo(x.z), bfhi(x.z), bflo(x.w), bfhi(x.w)} + 0.5f * acc[ai][bj][m][1];
                        ss += (v0[0] * v0[0] + v0[1] * v0[1]) + (v0[2] * v0[2] + v0[3] * v0[3]) + (v1[0] * v1[0] + v1[1] * v1[1]) + (v1[2] * v1[2] + v1[3] * v1[3]); }
                    ss += __shfl_xor(ss, 16); ss += __shfl_xor(ss, 32);
                    if (fq == 0) atomicAdd(rowsq + r, f2rq(ss)); }
                asm volatile("" ::: "memory"); }
        asm volatile("s_waitcnt vmcnt(0)" ::: "memory");
        unsigned* cw = cnt + 64 * u.pm;
        if ((threadIdx.x & 63) == 0) __hip_atomic_fetch_add(cw, 1u, __ATOMIC_RELAXED, __HIP_MEMORY_SCOPE_AGENT);
        { unsigned sp = 0;
          while ((unsigned)__builtin_amdgcn_readfirstlane(__hip_atomic_load(cw, __ATOMIC_RELAXED, __HIP_MEMORY_SCOPE_AGENT)) < 32u) { __builtin_amdgcn_s_sleep(2); if (++sp > (1u << 22)) break; } }
        f32x4 gv[2][2];
#pragma unroll
        for (int bj = 0; bj < 2; ++bj) { gv[bj][0] = *(const f32x4*)(gfin + col0 + bj * 128); gv[bj][1] = *(const f32x4*)(gfin + col0 + bj * 128 + 4); }
        u64 rqv[8];
#pragma unroll
        for (int i = 0; i < 8; ++i) rqv[i] = __hip_atomic_load(rowsq + row0 + (i >> 2) * 128 + (i & 3) * 16, __ATOMIC_RELAXED, __HIP_MEMORY_SCOPE_AGENT);
#pragma unroll
        for (int ai = 0; ai < 2; ++ai)
#pragma unroll
            for (int mp = 0; mp < 2; ++mp) {
                u32x4 w[2][2];
#pragma unroll
                for (int q = 0; q < 2; ++q)
#pragma unroll
                    for (int bj = 0; bj < 2; ++bj) w[q][bj] = *(const u32x4*)(hb + (size_t)(row0 + ai * 128 + (2 * mp + q) * 16) * DM + col0 + bj * 128);
#pragma unroll
                for (int q = 0; q < 2; ++q) { const int m = 2 * mp + q, r = row0 + ai * 128 + m * 16; float* op = out + (size_t)r * DM;
                    const float rs = rsqrtf(rq2f(rqv[ai * 4 + m]) * (1.0f / DM) + 1e-6f);
#pragma unroll
                    for (int bj = 0; bj < 2; ++bj) { const int c = col0 + bj * 128; const u32x4 x = w[q][bj];
                        const f32x4 v0 = (f32x4){bflo(x.x), bfhi(x.x), bflo(x.y), bfhi(x.y)} + 0.5f * acc[ai][bj][m][0], v1 = (f32x4){bflo(x.z), bfhi(x.z), bflo(x.w), bfhi(x.w)} + 0.5f * acc[ai][bj][m][1];
                        *(f32x4*)(op + c) = v0 * rs * gv[bj][0]; *(f32x4*)(op + c + 4) = v1 * rs * gv[bj][1]; } }
                asm volatile("" ::: "memory"); }
    }
};
struct EpiIn {
    static constexpr bool MID = false, PRE = false;
    const u64* rowsq; bf16_t* z; const float* tab;
    __device__ __forceinline__ void prefetch(float (&pre)[8], const Unit& u, int wr, int fr) const {
        const int row0 = u.pm * 256 + wr * 64 + fr;
#pragma unroll
        for (int i = 0; i < 8; ++i) pre[i] = __uint_as_float(rq_lo(rowsq, row0 + (i >> 2) * 128 + (i & 3) * 16));
    }
    __device__ __forceinline__ void operator()(AccRef acc, const Unit& u, int wr, int wc, int fr, int fq, const float (&pre)[8]) const {
        int row0 = u.pm * 256 + wr * 64 + fr; asm volatile("" : "+v"(row0));
        unsigned rq[8];
#pragma unroll
        for (int i = 0; i < 8; ++i) rq[i] = rq_lo(rowsq, row0 + (i >> 2) * 128 + (i & 3) * 16);
        if (u.pn < 4) {
            const bool isq = u.pn < 2; const int hh = wc >> 1, head = (u.pn & 1) * 2 + hh, j0 = 32 * (wc & 1) + 8 * fq;
            const float lg = log2_gamma(head);
#pragma unroll
            for (int ai = 0; ai < 2; ++ai)
#pragma unroll
                for (int mp = 0; mp < 2; ++mp) {
                    f32x4 t[2][4];
#pragma unroll
                    for (int q = 0; q < 2; ++q) { const int r = row0 + ai * 128 + (2 * mp + q) * 16; const int pos = (r & (SEQ - 1)) + NMETA; const f32x4* tp = (const f32x4*)(tab + ((size_t)pos * 64 + j0) * 2);
#pragma unroll
                        for (int k = 0; k < 4; ++k) t[q][k] = tp[k]; }
#pragma unroll
                    for (int q = 0; q < 2; ++q) { const int m = 2 * mp + q, r = row0 + ai * 128 + m * 16; const float rs = rsqrtf(rqlo2f(rq[ai * 4 + m]) * (1.0f / DM) + 1e-6f);
                        const int cidx = (r & (SEQ - 1)) & 127;
                        const float f = rs * (isq ? 0.08838834764831845f * exp2f((float)cidx * lg) : exp2f(-(float)cidx * lg));
                        bf16_t* zp = z + (size_t)r * NIN + u.pn * 256 + hh * 128 + j0;
#pragma unroll
                        for (int n = 0; n < 2; ++n) { const f32x4 ta = t[q][2 * n], tb = t[q][2 * n + 1]; const f32x4 x1 = acc[ai][0][m][n], x2 = acc[ai][1][m][n];
                            u32x2 w1, w2;
                            w1.x = cvt_pk_bf16((x1[0] * ta[0] - x2[0] * ta[1]) * f, (x1[1] * ta[2] - x2[1] * ta[3]) * f); w1.y = cvt_pk_bf16((x1[2] * tb[0] - x2[2] * tb[1]) * f, (x1[3] * tb[2] - x2[3] * tb[3]) * f);
                            w2.x = cvt_pk_bf16((x1[0] * ta[1] + x2[0] * ta[0]) * f, (x1[1] * ta[3] + x2[1] * ta[2]) * f); w2.y = cvt_pk_bf16((x1[2] * tb[1] + x2[2] * tb[0]) * f, (x1[3] * tb[3] + x2[3] * tb[2]) * f);
                            *(u32x2*)(zp + 4 * n) = w1; *(u32x2*)(zp + 64 + 4 * n) = w2; } }
                    asm volatile("" ::: "memory"); }
        } else {
            const int col0 = u.pn * 256 + wc * 32 + 8 * fq;
#pragma unroll
            for (int ai = 0; ai < 2; ++ai)
#pragma unroll
                for (int m = 0; m < 4; ++m) { const int r = row0 + ai * 128 + m * 16; const float rs = rsqrtf(rqlo2f(rq[ai * 4 + m]) * (1.0f / DM) + 1e-6f);
#pragma unroll
                    for (int bj = 0; bj < 2; ++bj) *(u32x4*)(z + (size_t)r * NIN + col0 + bj * 128) = pack8(acc[ai][bj][m][0] * rs, acc[ai][bj][m][1] * rs); }
        }
    }
};
struct EpiMix {
    static constexpr bool MID = true, PRE = false;
    bf16_t* z;
    static __device__ __forceinline__ float cl(float x) { return fminf(fmaxf(x, -30.f), 30.f); }
    __device__ __forceinline__ void mid(f32x4 (&acc)[2][2][4][2], const Unit& u, int wr, int wc, int fr, int fq) const {
        int row0 = u.pm * 256 + wr * 64 + fr; const int col0 = u.pn * 256 + wc * 32 + 8 * fq;
        asm volatile("" : "+v"(row0));
#pragma unroll
        for (int ai = 0; ai < 2; ++ai)
#pragma unroll
            for (int mp = 0; mp < 2; ++mp) {
                u32x4 ga[2][2], gb[2][2];
#pragma unroll
                for (int q = 0; q < 2; ++q) { const int r = row0 + ai * 128 + (2 * mp + q) * 16;
#pragma unroll
                    for (int bj = 0; bj < 2; ++bj) { const bf16_t* gp = z + (size_t)r * NIN + 2560 + col0 + bj * 128; ga[q][bj] = *(const u32x4*)gp; gb[q][bj] = *(const u32x4*)(gp + 1024); } }
#pragma unroll
                for (int q = 0; q < 2; ++q) { const int m = 2 * mp + q;
#pragma unroll
                    for (int bj = 0; bj < 2; ++bj)
#pragma unroll
                        for (int i = 0; i < 4; ++i) { const unsigned wa = ga[q][bj][i], wb = gb[q][bj][i];
                            const float r0 = (1.0f + expneg(cl(bflo(wb)))) * fast_rcp(1.0f + expneg(cl(bflo(wa))));
                            const float r1 = (1.0f + expneg(cl(bfhi(wb)))) * fast_rcp(1.0f + expneg(cl(bfhi(wa))));
                            acc[ai][bj][m][i >> 1][(i & 1) * 2] *= r0; acc[ai][bj][m][i >> 1][(i & 1) * 2 + 1] *= r1; } }
                asm volatile("" ::: "memory"); }
    }
    __device__ __forceinline__ void operator()(AccRef acc, const Unit& u, int wr, int wc, int fr, int fq, const float (&pre)[8]) const {
        const int row0 = u.pm * 256 + wr * 64 + fr, col0 = u.pn * 256 + wc * 32 + 8 * fq;
#pragma unroll
        for (int ai = 0; ai < 2; ++ai) {
            u32x4 gb[4][2];
#pragma unroll
            for (int m = 0; m < 4; ++m)
#pragma unroll
                for (int bj = 0; bj < 2; ++bj) gb[m][bj] = *(const u32x4*)(z + (size_t)(row0 + ai * 128 + m * 16) * NIN + 3584 + col0 + bj * 128);
#pragma unroll
            for (int m = 0; m < 4; ++m) { const int r = row0 + ai * 128 + m * 16;
#pragma unroll
                for (int bj = 0; bj < 2; ++bj) { const u32x4 g = gb[m][bj]; f32x4 o0, o1;
                    o0[0] = acc[ai][bj][m][0][0] * fast_rcp(1.0f + expneg(cl(bflo(g[0])))); o0[1] = acc[ai][bj][m][0][1] * fast_rcp(1.0f + expneg(cl(bfhi(g[0]))));
                    o0[2] = acc[ai][bj][m][0][2] * fast_rcp(1.0f + expneg(cl(bflo(g[1])))); o0[3] = acc[ai][bj][m][0][3] * fast_rcp(1.0f + expneg(cl(bfhi(g[1]))));
                    o1[0] = acc[ai][bj][m][1][0] * fast_rcp(1.0f + expneg(cl(bflo(g[2])))); o1[1] = acc[ai][bj][m][1][1] * fast_rcp(1.0f + expneg(cl(bfhi(g[2]))));
                    o1[2] = acc[ai][bj][m][1][2] * fast_rcp(1.0f + expneg(cl(bflo(g[3])))); o1[3] = acc[ai][bj][m][1][3] * fast_rcp(1.0f + expneg(cl(bfhi(g[3]))));
                    *(u32x4*)(z + (size_t)r * NIN + 1024 + col0 + bj * 128) = pack8(o0, o1); } }
            asm volatile("" ::: "memory"); }
    }
};

struct SkArgs { const bf16_t* A; int lda; const bf16_t* Bt; int K; const u64* rowsq_in; u64* rowsq_out; float* hmeta; bf16_t* hb; bf16_t* z; const float* tab; float scale; };
template <int MODE>
__device__ __forceinline__ void skinny(LAS unsigned char* lds, const SkArgs a) {
    int tid_ = threadIdx.x; asm volatile("" : "+v"(tid_));
    const int tid = tid_, lane = tid & 63, wave = __builtin_amdgcn_readfirstlane(tid >> 6), l15 = lane & 15, g = lane >> 4;
    constexpr int NITEMS = MODE == 0 ? 176 : (MODE == 2 ? 256 : 64);
    const int K = a.K;
    LAS f32x4* red = (LAS f32x4*)lds;
    for (int it = blockIdx.x; it < NITEMS; it += gridDim.x) {
        int brow0 = 16 * it, brow1 = 0; bool pair = false;
        if (MODE == 0) { const int hid = 16 * it; brow0 = ((hid >> 7) << 8) + (hid & 127); brow1 = brow0 + 128; pair = true; }
        if (MODE == 2) { if (it < 32) { brow0 = ((it >> 3) << 8) + (((it >> 2) & 1) << 6) + 16 * (it & 3); brow1 = brow0 + 128; pair = true; } else brow0 = 1024 + 16 * (it - 32); }
        int kb, ke;
        if (MODE == 3) { kb = (wave >> 2) * 512 + (wave & 3) * 128; ke = kb + 128; } else { const int kper = K >> 3; kb = wave * kper; ke = kb + kper; }
        f32x4 acc0 = (f32x4){0.f, 0.f, 0.f, 0.f}, acc1 = (f32x4){0.f, 0.f, 0.f, 0.f};
        const bf16_t* ap = a.A + (size_t)l15 * a.lda + 8 * g;
        const bf16_t* bp0 = a.Bt + (size_t)(brow0 + l15) * K + 8 * g;
        const bf16_t* bp1 = a.Bt + (size_t)(brow1 + l15) * K + 8 * g;
#pragma unroll 4
        for (int k = kb; k < ke; k += 32) { const bf16x8 av = *(const bf16x8*)(ap + k);
            acc0 = __builtin_amdgcn_mfma_f32_16x16x32_bf16(av, *(const bf16x8*)(bp0 + k), acc0, 0, 0, 0);
            if (pair) acc1 = __builtin_amdgcn_mfma_f32_16x16x32_bf16(av, *(const bf16x8*)(bp1 + k), acc1, 0, 0, 0); }
        red[(wave * 2 + 0) * 64 + lane] = acc0; red[(wave * 2 + 1) * 64 + lane] = acc1;
        __syncthreads();
        if (wave == 0) {
            f32x4 v0 = (f32x4){0.f, 0.f, 0.f, 0.f}, v1 = (f32x4){0.f, 0.f, 0.f, 0.f};
            if (MODE == 3) { for (int w = 0; w < 4; ++w) { v0 += red[(w * 2) * 64 + lane]; v1 += red[((w + 4) * 2) * 64 + lane]; } }
            else { for (int w = 0; w < 8; ++w) { v0 += red[(w * 2) * 64 + lane]; v1 += red[(w * 2 + 1) * 64 + lane]; } }
#pragma unroll
            for (int r = 0; r < 4; ++r) { const int row = 4 * g + r; const size_t R = (size_t)(TS + row);
                if (MODE == 0) { const float rs = rsqrtf(rq2f(a.rowsq_in[TS + row]) * (1.0f / DM) + 1e-6f);
                    a.z[R * FF + 16 * it + l15] = (bf16_t)(cvt_pk_bf16(silu_f(v0[r] * rs) * (v1[r] * rs), 0.f) & 0xffffu); }
                if (MODE == 1) { const int col = 16 * it + l15; const float hn = a.hmeta[(size_t)row * DM + col] + a.scale * v0[r];
                    a.hmeta[(size_t)row * DM + col] = hn; a.hb[R * DM + col] = (bf16_t)(cvt_pk_bf16(hn, 0.f) & 0xffffu);
                    float ss = hn * hn; ss += __shfl_xor(ss, 1); ss += __shfl_xor(ss, 2); ss += __shfl_xor(ss, 4); ss += __shfl_xor(ss, 8);
                    if (l15 == 0) atomicAdd(a.rowsq_out + TS + row, f2rq(ss)); }
                if (MODE == 2) { const float rs = rsqrtf(rq2f(a.rowsq_in[TS + row]) * (1.0f / DM) + 1e-6f);
                    if (it < 32) { const int pn = it >> 3, hh = (it >> 2) & 1, j = 16 * (it & 3) + l15, head = (pn & 1) * 2 + hh; const float lg = log2_gamma(head); const float cidx = (float)(112 + row);
                        const float f = rs * (pn < 2 ? 0.08838834764831845f * exp2f(cidx * lg) : exp2f(-cidx * lg));
                        const float c = a.tab[((size_t)row * 64 + j) * 2], sn = a.tab[((size_t)row * 64 + j) * 2 + 1];
                        bf16_t* zp = a.z + R * NIN + pn * 256 + hh * 128 + j;
                        zp[0] = (bf16_t)(cvt_pk_bf16((v0[r] * c - v1[r] * sn) * f, 0.f) & 0xffffu); zp[64] = (bf16_t)(cvt_pk_bf16((v0[r] * sn + v1[r] * c) * f, 0.f) & 0xffffu); }
                    else a.z[R * NIN + brow0 + l15] = (bf16_t)(cvt_pk_bf16(v0[r] * rs, 0.f) & 0xffffu); }
                if (MODE == 3) { const int col = 16 * it + l15; const float ga = bf2f(a.z[R * NIN + 2560 + col]), gb = bf2f(a.z[R * NIN + 3584 + col]);
                    const float mx = v0[r] * fast_rcp(1.0f + expneg(ga)) + v1[r] * fast_rcp(1.0f + expneg(gb));
                    a.z[R * NIN + 1024 + col] = (bf16_t)(cvt_pk_bf16(mx, 0.f) & 0xffffu); } }
        }
        __syncthreads();
    }
}

__device__ __forceinline__ int maprow(int map, int n) {
    if (map == 1) return ((n >> 7) << 8) + (n & 127);
    if (map == 2) return ((n >> 7) << 8) + 128 + (n & 127);
    if (map == 3) { if (n >= 1024) return n; const int pn = n >> 8, hh = (n >> 7) & 1, half = (n >> 6) & 1, j = n & 63; return (pn << 8) + (half << 7) + (hh << 6) + j; }
    return n;
}
__device__ __forceinline__ void conv_item(const float* src, int N, const float* gain, bf16_t* dst, int ldd, int koff, int map, int item, LAS float* scr, int lane) {
    const int nblk = N / 32, kb = item / nblk, nb = item % nblk, k0 = 64 * kb, n0 = 32 * nb;
    { f32x4 v[8]; const int kr = lane >> 3, n4 = lane & 7;
#pragma unroll
      for (int i = 0; i < 8; ++i) v[i] = *(const f32x4*)(src + (size_t)(k0 + 8 * i + kr) * N + n0 + 4 * n4);
#pragma unroll
      for (int i = 0; i < 8; ++i) { const int kk = 8 * i + kr; const float gg = gain ? gain[k0 + kk] : 1.0f; LAS float* d = scr + kk * 33 + 4 * n4;
          d[0] = v[i][0] * gg; d[1] = v[i][1] * gg; d[2] = v[i][2] * gg; d[3] = v[i][3] * gg; } }
    asm volatile("s_waitcnt lgkmcnt(0)" ::: "memory");
    const int c = lane & 7;
#pragma unroll
    for (int j = 0; j < 4; ++j) { const int n = (lane >> 3) + 8 * j; const LAS float* s = scr + (8 * c) * 33 + n;
        u32x4 o; o.x = cvt_pk_bf16(s[0 * 33], s[1 * 33]); o.y = cvt_pk_bf16(s[2 * 33], s[3 * 33]); o.z = cvt_pk_bf16(s[4 * 33], s[5 * 33]); o.w = cvt_pk_bf16(s[6 * 33], s[7 * 33]);
        *(u32x4*)(dst + (size_t)maprow(map, n0 + n) * ldd + koff + k0 + 8 * c) = o; }
    asm volatile("s_waitcnt lgkmcnt(0)" ::: "memory");
}
__device__ __forceinline__ void weff_item(const float* maps, const float* scale, const float* wp, bf16_t* dst, int item, int lane) {
    const int ab = item >> 4, nb = item & 15, i0 = 16 * ab, g = i0 >> 7, a0 = i0 & 127, n = 64 * nb + lane;
    const float* mp = maps + ((size_t)g * 128 + a0) * 128; const float* sc = scale + g * 128; const float* wc = wp + (size_t)(g * 128) * DM + n;
    float s[16];
#pragma unroll
    for (int a = 0; a < 16; ++a) s[a] = 0.f;
    for (int j = 0; j < 128; j += 4) {
        const float w0 = sc[j] * wc[(size_t)j * DM], w1 = sc[j + 1] * wc[(size_t)(j + 1) * DM], w2 = sc[j + 2] * wc[(size_t)(j + 2) * DM], w3 = sc[j + 3] * wc[(size_t)(j + 3) * DM];
#pragma unroll
        for (int a = 0; a < 16; ++a) { const float* m = mp + a * 128 + j; s[a] += m[0] * w0 + m[1] * w1 + m[2] * w2 + m[3] * w3; }
    }
    u32x4 o0, o1;
    o0.x = cvt_pk_bf16(s[0], s[1]); o0.y = cvt_pk_bf16(s[2], s[3]); o0.z = cvt_pk_bf16(s[4], s[5]); o0.w = cvt_pk_bf16(s[6], s[7]);
    o1.x = cvt_pk_bf16(s[8], s[9]); o1.y = cvt_pk_bf16(s[10], s[11]); o1.z = cvt_pk_bf16(s[12], s[13]); o1.w = cvt_pk_bf16(s[14], s[15]);
    bf16_t* d = dst + (size_t)n * DM + 512 + i0;
    *(u32x4*)d = o0; *(u32x4*)(d + 8) = o1;
}
__device__ __forceinline__ void row_to_bf16(const float* xrow, bf16_t* hbrow, float* hmrow, u64* rsq, int lane, bool zero) {
    f32x4 v[4]; float s = 0.f;
#pragma unroll
    for (int j = 0; j < 4; ++j) { v[j] = zero ? (f32x4){0.f, 0.f, 0.f, 0.f} : ((const f32x4*)xrow)[lane + 64 * j]; s += (v[j][0] * v[j][0] + v[j][1] * v[j][1]) + (v[j][2] * v[j][2] + v[j][3] * v[j][3]); }
    s = wave_sum(s);
#pragma unroll
    for (int j = 0; j < 4; ++j) { u32x2 w; w.x = cvt_pk_bf16(v[j][0], v[j][1]); w.y = cvt_pk_bf16(v[j][2], v[j][3]); ((u32x2*)hbrow)[lane + 64 * j] = w; if (hmrow) ((f32x4*)hmrow)[lane + 64 * j] = v[j]; }
    if (lane == 0) *rsq = f2rq(s);
}
__device__ __forceinline__ void phase_prep(const Params& P, LAS unsigned char* lds) {
    int tid_ = threadIdx.x; asm volatile("" : "+v"(tid_));
    const int tid = tid_, lane = tid & 63, wave = tid >> 6;
    const int gw = blockIdx.x * 8 + wave, NGW = gridDim.x * 8;
    LAS float* scr = (LAS float*)(lds + wave * 8448);
    unsigned char* ws = P.ws;
    constexpr int I_G = 16 * 88, I_D = 44 * 32, I_IN = 16 * 144, I_R = 8 * 32, I_O = 16 * 32;
    constexpr int PER_LAYER = 6 * I_G + I_IN + I_R + I_O;
    static_assert(I_G == I_D, "item counts");
    constexpr int NITEMS = 1024 + 2 * PER_LAYER;
    for (int it = gw; it < NITEMS; it += NGW) {
        if (it < 1024) { const int l = it >> 9, r = it & 511;
            weff_item(P.in[8] + (size_t)l * 4 * 128 * 128, P.in[9] + (size_t)l * 512, P.in[11] + (size_t)l * 512 * DM, (bf16_t*)(ws + WS_W + l * W_LAYER + W_WRP), r, lane); continue; }
        int r = it - 1024; const int l = r / PER_LAYER; r -= l * PER_LAYER;
        unsigned char* wl = ws + WS_W + l * W_LAYER;
        const float* n1 = P.in[2] + (size_t)l * DM; const float* nm = P.in[6] + (size_t)l * DM; const float* n2 = P.in[13] + (size_t)l * DM;
        if (r < I_G) { conv_item(P.in[3] + (size_t)l * DM * FF, FF, n1, (bf16_t*)(wl + W_W1), DM, 0, 1, r, scr, lane); continue; } r -= I_G;
        if (r < I_G) { conv_item(P.in[4] + (size_t)l * DM * FF, FF, n1, (bf16_t*)(wl + W_W1), DM, 0, 2, r, scr, lane); continue; } r -= I_G;
        if (r < I_D) { conv_item(P.in[5] + (size_t)l * FF * DM, DM, nullptr, (bf16_t*)(wl + W_W1D), FF, 0, 0, r, scr, lane); continue; } r -= I_D;
        if (r < I_IN) { conv_item(P.in[7] + (size_t)l * DM * NIN, NIN, nm, (bf16_t*)(wl + W_WIN), DM, 0, 3, r, scr, lane); continue; } r -= I_IN;
        if (r < I_R) { conv_item(P.in[10] + (size_t)l * 512 * DM, DM, nullptr, (bf16_t*)(wl + W_WRP), DM, 0, 0, r, scr, lane); continue; } r -= I_R;
        if (r < I_O) { conv_item(P.in[12] + (size_t)l * DM * DM, DM, nullptr, (bf16_t*)(wl + W_WO), DM, 0, 0, r, scr, lane); continue; } r -= I_O;
        if (r < I_G) { conv_item(P.in[14] + (size_t)l * DM * FF, FF, n2, (bf16_t*)(wl + W_W2), DM, 0, 1, r, scr, lane); continue; } r -= I_G;
        if (r < I_G) { conv_item(P.in[15] + (size_t)l * DM * FF, FF, n2, (bf16_t*)(wl + W_W2), DM, 0, 2, r, scr, lane); continue; } r -= I_G;
        conv_item(P.in[16] + (size_t)l * FF * DM, DM, nullptr, (bf16_t*)(wl + W_W2D), FF, 0, 0, r, scr, lane);
    }
    u64* rowsq = (u64*)(ws + WS_ROWSQ); bf16_t* hb = (bf16_t*)(ws + WS_HB); float* hmeta = (float*)(ws + WS_HMETA);
    for (int m = 2 * gw; m < TS; m += 2 * NGW) {
        const int m2 = m + 1; const f32x4* xa = (const f32x4*)(P.in[0] + (size_t)m * DM); const f32x4* xb = (const f32x4*)(P.in[0] + (size_t)m2 * DM);
        f32x4 va[4], vb[4]; float sa = 0.f, sb = 0.f;
#pragma unroll
        for (int j = 0; j < 4; ++j) { va[j] = xa[lane + 64 * j]; vb[j] = xb[lane + 64 * j]; }
#pragma unroll
        for (int j = 0; j < 4; ++j) { sa += (va[j][0] * va[j][0] + va[j][1] * va[j][1]) + (va[j][2] * va[j][2] + va[j][3] * va[j][3]); sb += (vb[j][0] * vb[j][0] + vb[j][1] * vb[j][1]) + (vb[j][2] * vb[j][2] + vb[j][3] * vb[j][3]); }
        sa = wave_sum(sa); sb = wave_sum(sb);
#pragma unroll
        for (int j = 0; j < 4; ++j) { u32x2 wa, wb; wa.x = cvt_pk_bf16(va[j][0], va[j][1]); wa.y = cvt_pk_bf16(va[j][2], va[j][3]); wb.x = cvt_pk_bf16(vb[j][0], vb[j][1]); wb.y = cvt_pk_bf16(vb[j][2], vb[j][3]);
            ((u32x2*)(hb + (size_t)m * DM))[lane + 64 * j] = wa; ((u32x2*)(hb + (size_t)m2 * DM))[lane + 64 * j] = wb; }
        if (lane == 0) { rowsq[m] = f2rq(sa); rowsq[m2] = f2rq(sb); } }
    for (int m = gw; m < NMETA; m += NGW) row_to_bf16(P.in[1] + (size_t)m * DM, hb + (size_t)(TS + m) * DM, hmeta + (size_t)m * DM, rowsq + TS + m, lane, false);
    const int gt = blockIdx.x * 512 + tid, NGT = gridDim.x * 512;
    for (int i = gt; i < 6 * TM; i += NGT) rowsq[TM + i] = 0ull;
    { unsigned* cnt = (unsigned*)(ws + WS_CNT); for (int i = gt; i < 128 * 64; i += NGT) cnt[i] = 0u; }
    float* tab = (float*)(ws + WS_TAB);
    for (int i = gt; i < NPOS * 64; i += NGT) { const int pos = i >> 6, j = i & 63;
        const double inv = exp2(-(double)j * (13.287712379549449 / 64.0)); const double ang = (double)pos * inv;
        const double k = rint(ang * 0.15915494309189535); const float rr = (float)(ang - k * 6.283185307179586);
        tab[2 * i] = cosf(rr); tab[2 * i + 1] = sinf(rr); }
}

__device__ __forceinline__ unsigned offb(unsigned row, unsigned ch) { return 256u * row + 16u * (ch ^ (((row & 3) << 2) | ((row >> 2) & 3))); }
__device__ __forceinline__ unsigned row_addr16(unsigned lane, unsigned rb, unsigned s) { return offb((lane & 15) + 16 * rb, 4 * s + (lane >> 4)); }
__device__ __forceinline__ unsigned tr_addr16(unsigned lane, unsigned c, unsigned ks, unsigned t) { const unsigned g = lane >> 4, q = (lane & 15) >> 2, p = lane & 3; return offb(32 * ks + 8 * g + 4 * t + q, 2 * c + (p >> 1)) + 8 * (p & 1); }
__device__ __forceinline__ bf16x8 tr_frag(unsigned tile, unsigned lane, unsigned c, unsigned ks) {
    u32x2 r0, r1; const unsigned a0 = tile + tr_addr16(lane, c, ks, 0), a1 = tile + tr_addr16(lane, c, ks, 1);
    asm volatile("ds_read_b64_tr_b16 %0, %2\n\tds_read_b64_tr_b16 %1, %3\n\ts_waitcnt lgkmcnt(0)" : "=&v"(r0), "=&v"(r1) : "v"(a0), "v"(a1) : "memory");
    u32x4 w; w.x = r0.x; w.y = r0.y; w.z = r1.x; w.w = r1.y; return __builtin_bit_cast(bf16x8, w);
}
__device__ __forceinline__ void tr_frag8(unsigned tile, unsigned lane, unsigned ks, bf16x8 (&f)[8]) {
    u32x2 r[16]; unsigned a[16];
#pragma unroll
    for (int c = 0; c < 8; ++c) { a[2 * c] = tile + tr_addr16(lane, c, ks, 0); a[2 * c + 1] = tile + tr_addr16(lane, c, ks, 1); }
    asm volatile("ds_read_b64_tr_b16 %0, %16\n\tds_read_b64_tr_b16 %1, %17\n\tds_read_b64_tr_b16 %2, %18\n\tds_read_b64_tr_b16 %3, %19\n\t"
                 "ds_read_b64_tr_b16 %4, %20\n\tds_read_b64_tr_b16 %5, %21\n\tds_read_b64_tr_b16 %6, %22\n\tds_read_b64_tr_b16 %7, %23\n\t"
                 "ds_read_b64_tr_b16 %8, %24\n\tds_read_b64_tr_b16 %9, %25\n\tds_read_b64_tr_b16 %10, %26\n\tds_read_b64_tr_b16 %11, %27\n\t"
                 "ds_read_b64_tr_b16 %12, %28\n\tds_read_b64_tr_b16 %13, %29\n\tds_read_b64_tr_b16 %14, %30\n\tds_read_b64_tr_b16 %15, %31\n\ts_waitcnt lgkmcnt(0)"
                 : "=&v"(r[0]), "=&v"(r[1]), "=&v"(r[2]), "=&v"(r[3]), "=&v"(r[4]), "=&v"(r[5]), "=&v"(r[6]), "=&v"(r[7]),
                   "=&v"(r[8]), "=&v"(r[9]), "=&v"(r[10]), "=&v"(r[11]), "=&v"(r[12]), "=&v"(r[13]), "=&v"(r[14]), "=&v"(r[15])
                 : "v"(a[0]), "v"(a[1]), "v"(a[2]), "v"(a[3]), "v"(a[4]), "v"(a[5]), "v"(a[6]), "v"(a[7]),
                   "v"(a[8]), "v"(a[9]), "v"(a[10]), "v"(a[11]), "v"(a[12]), "v"(a[13]), "v"(a[14]), "v"(a[15]) : "memory");
#pragma unroll
    for (int c = 0; c < 8; ++c) { u32x4 w; w.x = r[2 * c].x; w.y = r[2 * c].y; w.z = r[2 * c + 1].x; w.w = r[2 * c + 1].y; f[c] = __builtin_bit_cast(bf16x8, w); }
}
__device__ __forceinline__ bf16x8 row_frag(LAS unsigned char* tile, unsigned lane, unsigned rb, unsigned s) { return *(const LAS bf16x8*)(tile + row_addr16(lane, rb, s)); }

__device__ __forceinline__ void stage_ztile(const bf16_t* z, int b, int n, int cb, LAS unsigned char* tile, int tid) {
#pragma unroll
    for (int pass = 0; pass < 4; ++pass) { const int idx = tid + 512 * pass, row = idx >> 4, ch = idx & 15, p = n * 128 + row - 112;
        u32x4 v = (u32x4){0u, 0u, 0u, 0u};
        if (p >= 0) v = *(const u32x4*)(z + (size_t)zrow_of(b, p) * NIN + cb + ch * 8);
        *(LAS u32x4*)(tile + offb(row, ch)) = v; }
}
template <bool META> __device__ __forceinline__ void phase_ret(const Params& P, LAS unsigned char* lds);
template <bool LOWREG>
__device__ __forceinline__ void kv_compute(unsigned lbase_k, unsigned lbase_v, bf16_t* dst, int h, int lane, int wave) {
    const float g127 = exp2f(127.0f * log2_gamma(h));
    if constexpr (!LOWREG) {
        f32x4 acc[8];
#pragma unroll
        for (int i = 0; i < 8; ++i) acc[i] = (f32x4){0.f, 0.f, 0.f, 0.f};
#pragma unroll 1
        for (int ks = 0; ks < 4; ++ks) { const bf16x8 a = tr_frag(lbase_k, lane, wave, ks); bf16x8 vf[8]; tr_frag8(lbase_v, lane, ks, vf);
#pragma unroll
            for (int eb = 0; eb < 8; ++eb) acc[eb] = __builtin_amdgcn_mfma_f32_16x16x32_bf16(a, vf[eb], acc[eb], 0, 0, 0); }
#pragma unroll
        for (int eb = 0; eb < 8; ++eb) { u32x2 w; w.x = cvt_pk_bf16(acc[eb][0] * g127, acc[eb][1] * g127); w.y = cvt_pk_bf16(acc[eb][2] * g127, acc[eb][3] * g127);
            *(u32x2*)(dst + (size_t)(16 * eb + (lane & 15)) * 128 + 16 * wave + 4 * (lane >> 4)) = w; }
    } else {
#pragma unroll 1
        for (int eb = 0; eb < 8; ++eb) { f32x4 acc = (f32x4){0.f, 0.f, 0.f, 0.f};
#pragma unroll 1
            for (int ks = 0; ks < 4; ++ks) acc = __builtin_amdgcn_mfma_f32_16x16x32_bf16(tr_frag(lbase_k, lane, wave, ks), tr_frag(lbase_v, lane, eb, ks), acc, 0, 0, 0);
            u32x2 w; w.x = cvt_pk_bf16(acc[0] * g127, acc[1] * g127); w.y = cvt_pk_bf16(acc[2] * g127, acc[3] * g127);
            *(u32x2*)(dst + (size_t)(16 * eb + (lane & 15)) * 128 + 16 * wave + 4 * (lane >> 4)) = w; }
    }
}
__device__ __forceinline__ void phase_kv(const Params& P, LAS unsigned char* lds) {
    int tid_ = threadIdx.x; asm volatile("" : "+v"(tid_));
    const int tid = tid_, lane = tid & 63, wave = __builtin_amdgcn_readfirstlane(tid >> 6);
    const bf16_t* z = (const bf16_t*)(P.ws + WS_Z); bf16_t* G = (bf16_t*)(P.ws + WS_G);
    const unsigned lbase = (unsigned)(uintptr_t)lds;
    for (int it = blockIdx.x; it < 224; it += gridDim.x) {
        const int grp = it % 7, h = (it / 7) & 3, b = it / 28;
        const float lg = log2_gamma(h), cd = exp2f(128.0f * lg), g127 = exp2f(127.0f * lg);
        f32x4 acc[8];
#pragma unroll
        for (int i = 0; i < 8; ++i) acc[i] = (f32x4){0.f, 0.f, 0.f, 0.f};
#pragma unroll 1
        for (int j = 0; j < 4; ++j) { const int n = 4 * grp + 1 + j;
            stage_ztile(z, b, n, 512 + h * 128, lds, tid);
            stage_ztile(z, b, n, 1024 + h * 128, lds + 32768, tid);
            __syncthreads();
#pragma unroll
            for (int i = 0; i < 8; ++i) acc[i] = acc[i] * cd;
#pragma unroll 1
            for (int ks = 0; ks < 4; ++ks) { const bf16x8 a = tr_frag(lbase, lane, wave, ks); bf16x8 vf[8]; tr_frag8(lbase + 32768, lane, ks, vf);
#pragma unroll
                for (int eb = 0; eb < 8; ++eb) acc[eb] = __builtin_amdgcn_mfma_f32_16x16x32_bf16(a, vf[eb], acc[eb], 0, 0, 0); }
            __syncthreads(); }
        bf16_t* dst = G + ((size_t)((b * 4 + h) * 8 + grp)) * 16384;
#pragma unroll
        for (int eb = 0; eb < 8; ++eb) { u32x2 w; w.x = cvt_pk_bf16(acc[eb][0] * g127, acc[eb][1] * g127); w.y = cvt_pk_bf16(acc[eb][2] * g127, acc[eb][3] * g127);
            *(u32x2*)(dst + (size_t)(16 * eb + (lane & 15)) * 128 + 16 * wave + 4 * (lane >> 4)) = w; }
    }
    phase_ret<true>(P, lds);
}
template <int W> __device__ __forceinline__ void pool_part(bf16_t* z, int b, int n, int h, int tid) {
    const int j = tid & 127, qd = tid >> 7, colu = 2048 + h * 128 + j;
    constexpr int SB = 8;
#pragma unroll 1
    for (int sb = 0; sb < 32 / SB; ++sb) {
        const int p0 = n * 128 - 112 + 32 * qd + SB * sb;
        float u[SB + W - 1];
#pragma unroll
        for (int i = 0; i < SB + W - 1; ++i) { const int p = p0 - (W - 1) + i; u[i] = p >= 0 ? bf2f(z[(size_t)zrow_of(b, p) * NIN + colu]) : 0.f; }
        float sum = 0.f;
#pragma unroll
        for (int i = 0; i < W - 1; ++i) sum += u[i];
        float o[SB];
#pragma unroll
        for (int t = 0; t < SB; ++t) { const int p = p0 + t; const float ut = u[t + W - 1]; sum += ut;
            const float mean = (p + 1 < W) ? sum / (float)(p + 1 > 0 ? p + 1 : 1) : sum * (1.0f / (float)W);
            o[t] = mean - ut; sum -= u[t]; }
#pragma unroll
        for (int t = 0; t < SB; ++t) { const int p = p0 + t; if (p >= 0) z[(size_t)zrow_of(b, p) * NIN + 512 + h * 128 + j] = (bf16_t)(cvt_pk_bf16(o[t], 0.f) & 0xffffu); }
    }
}
template <bool META> __device__ __forceinline__ void phase_ret(const Params& P, LAS unsigned char* lds) {
    int tid_ = threadIdx.x; asm volatile("" : "+v"(tid_));
    const int tid = tid_, lane = tid & 63, wave = __builtin_amdgcn_readfirstlane(tid >> 6), g = lane >> 4, l15 = lane & 15;
    bf16_t* z = (bf16_t*)(P.ws + WS_Z); const bf16_t* G = (const bf16_t*)(P.ws + WS_G);
    const unsigned lbase = (unsigned)(uintptr_t)lds;
    LAS unsigned char* tq = lds; LAS unsigned char* tk = lds + 32768; LAS unsigned char* tst = lds + 98304;
    const int it_first = META ? (int)blockIdx.x - ((int)gridDim.x - 4) + 1024 : (int)blockIdx.x, it_end = META ? ((int)blockIdx.x >= (int)gridDim.x - 4 ? it_first + 1 : 0) : 256;
    for (int it = it_first; it < it_end; it += gridDim.x) {
        int grp, h, b; if (!META) { grp = it & 7; h = (it >> 3) & 3; b = it >> 5; } else { grp = 0; b = 0; h = it - 1024; asm volatile("" : "+s"(grp), "+s"(b)); }
        const float lg = log2_gamma(h), cd = exp2f(128.0f * lg);
        {
          const float gam = exp2f(lg); const bf16_t* kv0 = (const bf16_t*)(P.ws + WS_KV0) + (size_t)h * 16384; const bf16_t* gb = G + ((size_t)((b * 4 + h) * 8)) * 16384;
#pragma unroll 1
          for (int pass = 0; pass < 4; ++pass) { const int idx = tid + 512 * pass, row = idx >> 4, ch = idx & 15;
              float a[8];
#pragma unroll
              for (int i = 0; i < 8; ++i) a[i] = 0.f;
              if (!META) {
                  { const u32x4 v = *(const u32x4*)(kv0 + row * 128 + ch * 8); const float w = gam * exp2f(512.0f * lg * (float)grp);
#pragma unroll
                    for (int i = 0; i < 4; ++i) { a[2 * i] += w * bflo(v[i]); a[2 * i + 1] += w * bfhi(v[i]); } }
                  for (int gp = 0; gp < grp; ++gp) { const u32x4 v = *(const u32x4*)(gb + (size_t)gp * 16384 + row * 128 + ch * 8); const float w = gam * exp2f(512.0f * lg * (float)(grp - 1 - gp));
#pragma unroll
                    for (int i = 0; i < 4; ++i) { a[2 * i] += w * bflo(v[i]); a[2 * i + 1] += w * bfhi(v[i]); } } }
              u32x4 o; o.x = cvt_pk_bf16(a[0], a[1]); o.y = cvt_pk_bf16(a[2], a[3]); o.z = cvt_pk_bf16(a[4], a[5]); o.w = cvt_pk_bf16(a[6], a[7]);
              *(LAS u32x4*)(tst + offb(row, ch)) = o; } }
#pragma unroll 1
        for (int j = 0; j < (META ? 1 : 4); ++j) {
        const int n = META ? 0 : 4 * grp + 1 + j;
        stage_ztile(z, b, n, h * 128, tq, tid);
        stage_ztile(z, b, n, 512 + h * 128, tk, tid);
        stage_ztile(z, b, n, 1024 + h * 128, lds + 65536, tid);
        __syncthreads();
        f32x4 acc2[8];
#pragma unroll
        for (int i = 0; i < 8; ++i) acc2[i] = (f32x4){0.f, 0.f, 0.f, 0.f};
        const bool upd = !META && (j < 3);
        if (upd) {
#pragma unroll 1
            for (int ks = 0; ks < 4; ++ks) { const bf16x8 a = tr_frag(lbase + 32768, lane, wave, ks); bf16x8 vf[8]; tr_frag8(lbase + 65536, lane, ks, vf);
#pragma unroll
                for (int eb = 0; eb < 8; ++eb) acc2[eb] = __builtin_amdgcn_mfma_f32_16x16x32_bf16(a, vf[eb], acc2[eb], 0, 0, 0); } }
        if constexpr (META) kv_compute<true>(lbase + 32768, lbase + 65536, (bf16_t*)(P.ws + WS_KV0) + (size_t)h * 16384, h, lane, wave);
        switch (h) { case 0: pool_part<2>(z, b, n, h, tid); break; case 1: pool_part<4>(z, b, n, h, tid); break; case 2: pool_part<8>(z, b, n, h, tid); break; default: pool_part<16>(z, b, n, h, tid); break; }
        f32x4 acc[8];
#pragma unroll
        for (int i = 0; i < 8; ++i) acc[i] = (f32x4){0.f, 0.f, 0.f, 0.f};
        {
        bf16x8 qc[4];
#pragma unroll
        for (int ks = 0; ks < 4; ++ks) qc[ks] = row_frag(tq, lane, wave, ks);
#pragma unroll
        for (int ks = 0; ks < 4; ++ks) {
#pragma unroll
            for (int eb = 0; eb < 8; ++eb) acc[eb] = __builtin_amdgcn_mfma_f32_16x16x32_bf16(qc[ks], row_frag(tst, lane, eb, ks), acc[eb], 0, 0, 0);
            __builtin_amdgcn_sched_barrier(0); }
        }
        if (upd) {
            __syncthreads();
#pragma unroll
            for (int eb = 0; eb < 8; ++eb) { LAS u32x2* tp = (LAS u32x2*)(tst + offb(16 * eb + l15, 2 * wave + (g >> 1)) + 8 * (g & 1)); const u32x2 o = *tp; u32x2 w;
                w.x = cvt_pk_bf16(cd * (bflo(o.x) + acc2[eb][0]), cd * (bfhi(o.x) + acc2[eb][1])); w.y = cvt_pk_bf16(cd * (bflo(o.y) + acc2[eb][2]), cd * (bfhi(o.y) + acc2[eb][3])); *tp = w; }
        }
        bf16x8 qf[4];
#pragma unroll
        for (int ks = 0; ks < 4; ++ks) qf[ks] = row_frag(tq, lane, wave, ks);
        u32x2 pk[8];
#pragma unroll
        for (int mb = 0; mb < 8; ++mb) { f32x4 s = (f32x4){0.f, 0.f, 0.f, 0.f};
            if (mb <= wave) {
#pragma unroll
            for (int ks = 0; ks < 4; ++ks) s = __builtin_amdgcn_mfma_f32_16x16x32_bf16(row_frag(tk, lane, mb, ks), qf[ks], s, 0, 0, 0); }
            const int c = 16 * wave + l15, m0 = 16 * mb + 4 * g;
#pragma unroll
            for (int r = 0; r < 4; ++r) if (m0 + r > c) s[r] = 0.f;
            pk[mb].x = cvt_pk_bf16(s[0], s[1]); pk[mb].y = cvt_pk_bf16(s[2], s[3]); __builtin_amdgcn_sched_barrier(0); }
        __syncthreads();
#pragma unroll
        for (int mb = 0; mb < 8; ++mb) *(LAS u32x2*)(tk + offb(16 * wave + l15, 2 * mb + (g >> 1)) + 8 * (g & 1)) = pk[mb];
#pragma unroll 1
        for (int ks = 0; ks < 4; ++ks) { if (2 * ks <= wave) {
            const bf16x8 pf = row_frag(tk, lane, wave, ks); bf16x8 vf[8]; tr_frag8(lbase + 65536, lane, ks, vf);
#pragma unroll
            for (int eb = 0; eb < 8; ++eb) acc[eb] = __builtin_amdgcn_mfma_f32_16x16x32_bf16(pf, vf[eb], acc[eb], 0, 0, 0); } }
#pragma unroll
        for (int r = 0; r < 4; ++r) { float s = 0.f;
#pragma unroll
            for (int eb = 0; eb < 8; ++eb) s += acc[eb][r];
            s += __shfl_xor(s, 1); s += __shfl_xor(s, 2); s += __shfl_xor(s, 4); s += __shfl_xor(s, 8);
            const float mu = s * (1.0f / 128.0f); float q = 0.f;
#pragma unroll
            for (int eb = 0; eb < 8; ++eb) { const float d = acc[eb][r] - mu; q += d * d; }
            q += __shfl_xor(q, 1); q += __shfl_xor(q, 2); q += __shfl_xor(q, 4); q += __shfl_xor(q, 8);
            const float rstd = rsqrtf(q * (1.0f / 128.0f) + 1e-6f);
            const int c = 16 * wave + 4 * g + r;
#pragma unroll
            for (int eb = 0; eb < 8; ++eb) { const int e = 16 * eb + l15;
                *(LAS bf16_t*)(tq + offb(c, e >> 3) + (e & 7) * 2) = (bf16_t)(cvt_pk_bf16((acc[eb][r] - mu) * rstd, 0.f) & 0xffffu); } }
#pragma unroll
        for (int i = 0; i < 4; ++i) { const int idx = lane + 64 * i, c = 16 * wave + (idx >> 4), ch = idx & 15, p = n * 128 + c - 112;
            if (p >= 0) { const size_t zr = (size_t)zrow_of(b, p) * NIN;
                const u32x4 y = *(const LAS u32x4*)(tq + offb(c, ch)); const u32x4 gg = *(const u32x4*)(z + zr + 1536 + h * 128 + ch * 8);
                u32x4 o;
#pragma unroll
                for (int k = 0; k < 4; ++k) o[k] = cvt_pk_bf16(bflo(y[k]) * silu_f(bflo(gg[k])), bfhi(y[k]) * silu_f(bfhi(gg[k])));
                *(u32x4*)(z + zr + h * 128 + ch * 8) = o; } }
        __syncthreads();
        }
    }
}
__device__ __forceinline__ void phase_final(const Params& P) {
    int tid_ = threadIdx.x; asm volatile("" : "+v"(tid_));
    const int tid = tid_, lane = tid & 63, wave = tid >> 6; const int gw = blockIdx.x * 8 + wave, NGW = gridDim.x * 8;
    const u64* rowsq = (const u64*)(P.ws + WS_ROWSQ) + (size_t)6 * TM; const f32x4* gn = (const f32x4*)P.in[17];
    f32x4 gv[4];
#pragma unroll
    for (int j = 0; j < 4; ++j) gv[j] = gn[lane + 64 * j];
    for (int m = gw; m < TS; m += NGW) { const float rs = rsqrtf(rq2f(rowsq[m]) * (1.0f / DM) + 1e-6f); f32x4* o = (f32x4*)(P.out + (size_t)m * DM);
#pragma unroll
        for (int j = 0; j < 4; ++j) o[lane + 64 * j] = o[lane + 64 * j] * rs * gv[j]; }
}

__global__ void __launch_bounds__(512, 2) mk_fwd(Params P) {
    extern __shared__ __attribute__((aligned(16))) unsigned char lds_raw[];
    LAS unsigned char* lds = (LAS unsigned char*)lds_raw;
    cg::grid_group grid = cg::this_grid();
    const int lo = P.ph_lo, hi = P.ph_hi;
    unsigned char* ws = P.ws;
    u64* rowsq = (u64*)(ws + WS_ROWSQ); float* hmeta = (float*)(ws + WS_HMETA); bf16_t* hb = (bf16_t*)(ws + WS_HB); bf16_t* z = (bf16_t*)(ws + WS_Z);
    const float* tab = (const float*)(ws + WS_TAB);
#define IN(k) (lo <= (k) && (k) < hi)
    { LAS unsigned* stw = (LAS unsigned*)(lds + 131072); if (threadIdx.x < 4) stw[threadIdx.x] = 0u; }
    __syncthreads();
    const XcdBarrier xbar = xcd_barrier_post((unsigned*)(ws + WS_BAR), (volatile LAS unsigned*)(lds + 131072));
    if (lo < 0) grid.sync();
#define SEAM(k) do { if ((k) + 1 < hi) xcd_barrier(xbar); } while (0)
    if (IN(0)) { if (PHMASK & 1) phase_prep(P, lds); SEAM(0); }
    for (int l = 0; l < 2; ++l) {
        const int pb = 1 + 10 * l; unsigned char* wl = ws + WS_W + l * W_LAYER;
        pg8::StaticOrder S;
        if (IN(pb + 0)) { pg8::Gemm g{hb, (const bf16_t*)(wl + W_W1), TS, 2 * FF, DM, DM}; S.init(TS, 2 * FF, gridDim.x, blockIdx.x);
            if (PHMASK & 256) skinny<0>(lds, SkArgs{hb + (size_t)TS * DM, DM, (const bf16_t*)(wl + W_W1), DM, rowsq + (size_t)(3 * l) * TM, nullptr, hmeta, hb, z, tab, 0.f});
            EpiUp E{rowsq + (size_t)(3 * l) * TM, z}; if (PHMASK & 2) pg8::gemm_phase(lds, g, S, E); SEAM(pb + 0); }
        if (IN(pb + 1)) { pg8::Gemm g{z, (const bf16_t*)(wl + W_W1D), TS, DM, FF, FF}; S.init(TS, DM, gridDim.x, blockIdx.x);
            if (PHMASK & 256) skinny<1>(lds, SkArgs{z + (size_t)TS * FF, FF, (const bf16_t*)(wl + W_W1D), FF, nullptr, rowsq + (size_t)(3 * l + 1) * TM, hmeta, hb, z, tab, 0.5f});
            EpiDown<false, false> E{l == 0 ? P.in[0] : P.out, nullptr, hb, rowsq + (size_t)(3 * l + 1) * TM, 0.5f}; if (PHMASK & 4) pg8::gemm_phase(lds, g, S, E); SEAM(pb + 1); }
        if (IN(pb + 2)) { pg8::Gemm g{hb, (const bf16_t*)(wl + W_WIN), TS, NIN, DM, DM}; S.init(TS, NIN, gridDim.x, blockIdx.x);
            if (PHMASK & 256) skinny<2>(lds, SkArgs{hb + (size_t)TS * DM, DM, (const bf16_t*)(wl + W_WIN), DM, rowsq + (size_t)(3 * l + 1) * TM, nullptr, hmeta, hb, z, tab, 0.f});
            EpiIn E{rowsq + (size_t)(3 * l + 1) * TM, z, tab}; if (PHMASK & 8) pg8::gemm_phase(lds, g, S, E); SEAM(pb + 2); }
        if (IN(pb + 3)) { if (PHMASK & 16) phase_kv(P, lds); SEAM(pb + 3); }
        if (IN(pb + 5)) { if (PHMASK & 64) phase_ret<false>(P, lds); SEAM(pb + 5); }
        if (IN(pb + 6)) { pg8::Gemm g{z, (const bf16_t*)(wl + W_WRP), TS, DM, DM, NIN}; S.init(TS, DM, gridDim.x, blockIdx.x);
            if (PHMASK & 256) skinny<3>(lds, SkArgs{z + (size_t)TS * NIN, NIN, (const bf16_t*)(wl + W_WRP), DM, nullptr, nullptr, hmeta, hb, z, tab, 0.f});
            EpiMix E{z}; if (PHMASK & 128) pg8::gemm_phase(lds, g, S, E); SEAM(pb + 6); }
        if (IN(pb + 7)) { pg8::Gemm g{z + 1024, (const bf16_t*)(wl + W_WO), TS, DM, DM, NIN}; S.init(TS, DM, gridDim.x, blockIdx.x);
            if (PHMASK & 256) skinny<1>(lds, SkArgs{z + (size_t)TS * NIN + 1024, NIN, (const bf16_t*)(wl + W_WO), DM, nullptr, rowsq + (size_t)(3 * l + 2) * TM, hmeta, hb, z, tab, 1.0f});
            EpiDown<true, false> E{nullptr, nullptr, hb, rowsq + (size_t)(3 * l + 2) * TM, 1.0f}; pg8::gemm_phase(lds, g, S, E); SEAM(pb + 7); }
        if (IN(pb + 8)) { pg8::Gemm g{hb, (const bf16_t*)(wl + W_W2), TS, 2 * FF, DM, DM}; S.init(TS, 2 * FF, gridDim.x, blockIdx.x);
            if (PHMASK & 256) skinny<0>(lds, SkArgs{hb + (size_t)TS * DM, DM, (const bf16_t*)(wl + W_W2), DM, rowsq + (size_t)(3 * l + 2) * TM, nullptr, hmeta, hb, z, tab, 0.f});
            EpiUp E{rowsq + (size_t)(3 * l + 2) * TM, z}; pg8::gemm_phase(lds, g, S, E); SEAM(pb + 8); }
        if (IN(pb + 9)) { pg8::Gemm g{z, (const bf16_t*)(wl + W_W2D), TS, DM, FF, FF}; S.init(TS, DM, gridDim.x, blockIdx.x);
            if (PHMASK & 256) skinny<1>(lds, SkArgs{z + (size_t)TS * FF, FF, (const bf16_t*)(wl + W_W2D), FF, nullptr, rowsq + (size_t)(3 * l + 3) * TM, hmeta, hb, z, tab, 0.5f});
            const bool fuse_final = (l == 1) && (gridDim.x == 256);
            if (fuse_final) { EpiFinal E{P.out, hb, rowsq + (size_t)6 * TM, (unsigned*)(ws + WS_CNT), P.in[17]}; pg8::gemm_phase(lds, g, S, E); }
            else { EpiDown<true, true> E{nullptr, P.out, hb, rowsq + (size_t)(3 * l + 3) * TM, 0.5f}; pg8::gemm_phase(lds, g, S, E); }
            if (l == 1 && !fuse_final) { xcd_barrier(xbar); phase_final(P); }
            SEAM(pb + 9); }
    }
#undef IN
#undef SEAM
}

extern "C" void kernel_launch(void* const* d_in, const int* in_sizes, int n_in, void* d_out, int out_size, void* d_ws, size_t ws_size, hipStream_t stream) {
    static int grid = 0;
    if (grid == 0) {
        if (n_in != 18 || in_sizes[0] != TS * DM || out_size != TS * DM || ws_size < WS_END) { fprintf(stderr, "kernel_launch: unexpected shapes (n_in %d, in0 %d, out %d, ws %zu < %zu)\n", n_in, n_in > 0 ? in_sizes[0] : -1, out_size, ws_size, (size_t)WS_END); grid = -1; return; }
        int dev = 0, cus = 0, per_cu = 0;
        hipGetDevice(&dev); hipDeviceGetAttribute(&cus, hipDeviceAttributeMultiprocessorCount, dev);
        if (hipFuncSetAttribute((const void*)mk_fwd, hipFuncAttributeMaxDynamicSharedMemorySize, LDS_BYTES) != hipSuccess) { fprintf(stderr, "kernel_launch: hipFuncSetAttribute failed\n"); grid = -1; return; }
        if (hipOccupancyMaxActiveBlocksPerMultiprocessor(&per_cu, (const void*)mk_fwd, 512, LDS_BYTES) != hipSuccess || per_cu < 1) { fprintf(stderr, "kernel_launch: occupancy query says %d blocks/CU\n", per_cu); per_cu = 1; }
        (void)hipGetLastError();
        grid = cus * per_cu;
    }
    if (grid < 0) return;
    Params p{};
    for (int i = 0; i < 18; ++i) p.in[i] = (const float*)d_in[i];
    p.out = (float*)d_out; p.ws = (unsigned char*)d_ws;
#if MK_MULTI
    for (int ph = 0; ph < NPH; ++ph) { p.ph_lo = ph; p.ph_hi = ph + 1; hipLaunchKernelGGL(mk_fwd, dim3(grid), dim3(512), LDS_BYTES, stream, p); }
#else
    p.ph_lo = 0; p.ph_hi = NPH;
    (void)hipMemsetAsync((unsigned char*)d_ws + WS_BAR, 0, XCD_BAR_WORDS * 4, stream);
    void* args[] = {&p};
    hipError_t e = hipLaunchCooperativeKernel((const void*)mk_fwd, dim3(grid), dim3(512), args, LDS_BYTES, stream);
    if (e != hipSuccess) fprintf(stderr, "cooperative launch failed: %s (grid %d)\n", hipGetErrorString(e), grid);
#endif
}
```

```cpp
#include <hip/hip_runtime.h>
#include <hip/hip_cooperative_groups.h>
#include <cstdio>
#include <cstdint>
namespace cg = cooperative_groups;

#ifndef PHMASK
#define PHMASK 0xffff
#endif
#ifndef MK_MULTI
#define MK_MULTI 0
#endif

#define LAS __attribute__((address_space(3)))
typedef unsigned short bf16_t;
typedef short bf16x8 __attribute__((ext_vector_type(8)));
typedef float f32x4 __attribute__((ext_vector_type(4)));
typedef unsigned u32x4 __attribute__((ext_vector_type(4)));
typedef unsigned u32x2 __attribute__((ext_vector_type(2)));
typedef unsigned long long u64;
__device__ __forceinline__ u64 f2rq(float s) { return (u64)(s * 4096.0f + 0.5f); }
__device__ __forceinline__ float rq2f(u64 q) { return (float)(unsigned)q * (1.0f / 4096.0f); }
__device__ __forceinline__ unsigned rq_lo(const u64* p, int idx) { return ((const unsigned*)p)[2 * idx]; }
__device__ __forceinline__ float rqlo2f(unsigned lo) { return (float)lo * (1.0f / 4096.0f); }

constexpr int DM = 1024, NBATCH = 8, SEQ = 4096, NMETA = 16, FF = 2816, NIN = 4608;
constexpr int TS = NBATCH * SEQ;
constexpr int TM = 33024;
constexpr int NPOS = SEQ + NMETA;
constexpr int NCH = 33;
constexpr int NPH = 21;
constexpr int LDS_BYTES = 131072 + 16;

constexpr size_t WS_ROWSQ = 0;
constexpr size_t WS_BAR   = 1900544;
constexpr size_t WS_CNT   = WS_BAR + 16384;
constexpr size_t WS_TAB   = 2u << 20;
constexpr size_t WS_HMETA = WS_TAB + (size_t)NPOS * 64 * 8 + 65536 - ((size_t)NPOS * 64 * 8) % 65536;
constexpr size_t WS_KV0   = WS_HMETA + 256 * 1024 * 4;
constexpr size_t WS_W     = WS_KV0 + 4 * 16384 * 4;
constexpr size_t W_W1 = 0, W_W1D = W_W1 + (size_t)2 * FF * DM * 2, W_WIN = W_W1D + (size_t)DM * FF * 2, W_WRP = W_WIN + (size_t)NIN * DM * 2,
                 W_WO = W_WRP + (size_t)DM * DM * 2, W_W2 = W_WO + (size_t)DM * DM * 2, W_W2D = W_W2 + (size_t)2 * FF * DM * 2, W_LAYER = W_W2D + (size_t)DM * FF * 2;
constexpr size_t WS_HB    = WS_W + 2 * W_LAYER;
constexpr size_t HB_BYTES = (size_t)NBATCH * 4 * NCH * 16384 * 4;
constexpr size_t WS_Z     = WS_HB + HB_BYTES;
constexpr size_t WS_G     = WS_Z + (size_t)TM * NIN * 2;
constexpr size_t WS_END   = WS_G + (size_t)NBATCH * 4 * 8 * 16384 * 2;

struct Params { const float* in[18]; float* out; unsigned char* ws; int ph_lo, ph_hi; };

__device__ __forceinline__ unsigned cvt_pk_bf16(float lo, float hi) { unsigned r; asm("v_cvt_pk_bf16_f32 %0, %1, %2" : "=v"(r) : "v"(lo), "v"(hi)); return r; }
__device__ __forceinline__ float bflo(unsigned w) { return __uint_as_float(w << 16); }
__device__ __forceinline__ float bfhi(unsigned w) { return __uint_as_float(w & 0xffff0000u); }
__device__ __forceinline__ float bf2f(bf16_t b) { return __uint_as_float(((unsigned)b) << 16); }
__device__ __forceinline__ float fast_rcp(float x) { return __builtin_amdgcn_rcpf(x); }
__device__ __forceinline__ float expneg(float x) { return __expf(-x); }
__device__ __forceinline__ float silu_f(float x) { return x * fast_rcp(1.0f + expneg(x)); }
__device__ __forceinline__ float wave_sum(float v) {
#pragma unroll
    for (int o = 1; o < 64; o <<= 1) v += __shfl_xor(v, o);
    return v;
}
__device__ __forceinline__ int zrow_of(int b, int p) { return p < NMETA ? TS + p : b * SEQ + (p - NMETA); }
__device__ __forceinline__ float log2_gamma(int head) { return log2f(1.0f - exp2f(-5.0f - (float)head)); }


#define XB_TMO      128
#define XB_XCNT(j)  (256  + 64 * (j))
#define XB_XSUB(j)  (1280 + 64 * (j))
#define XB_XGEN(j)  (2304 + 64 * (j))
#define XB_TOP      3328
#define XB_TOPGEN   3392
#define XCD_BAR_WORDS 3456
#define XB_SPIN_CAP (1u << 18)
__device__ __forceinline__ unsigned xb_ld(unsigned* p)              { return __hip_atomic_load(p, __ATOMIC_RELAXED, __HIP_MEMORY_SCOPE_AGENT); }
__device__ __forceinline__ unsigned xb_add(unsigned* p, unsigned v) { return __hip_atomic_fetch_add(p, v, __ATOMIC_RELAXED, __HIP_MEMORY_SCOPE_AGENT); }
__device__ __forceinline__ unsigned xb_xcc_id() { return (unsigned)__builtin_amdgcn_s_getreg((3 << 11) | 20) & 0xFu; }
#define XB_SPIN(cond, bar) do { unsigned _sp = 0; while (cond) { __builtin_amdgcn_s_sleep(1); \
    if ((++_sp & 255u) == 0u) { if (xb_ld(&(bar)[XB_TMO])) break; if (_sp > XB_SPIN_CAP) { atomicAdd(&(bar)[XB_TMO], 1u); break; } } } } while (0)
struct XcdBarrier { unsigned* bar; unsigned x; volatile LAS unsigned* st; };
__device__ __forceinline__ XcdBarrier xcd_barrier_post(unsigned* bar, volatile LAS unsigned* st) {
    XcdBarrier b; b.bar = bar; b.x = xb_xcc_id(); b.st = st;
    if (threadIdx.x == 0) (void)xb_add(&bar[XB_XCNT(b.x)], 1u);
    return b;
}
__device__ __forceinline__ void xcd_barrier_complete(unsigned* bar, unsigned x, unsigned& nloc, unsigned& nx) {
    const unsigned G = gridDim.x * gridDim.y * gridDim.z;
    unsigned sum, cnt, mine, sp = 0u;
    for (;;) {
        sum = 0u; cnt = 0u; mine = 0u;
#pragma unroll
        for (unsigned j = 0; j < 16; ++j) { const unsigned c = xb_ld(&bar[XB_XCNT(j)]); sum += c; cnt += (c > 0u) ? 1u : 0u; mine = (j == x) ? c : mine; }
        if (sum == G) break;
        __builtin_amdgcn_s_sleep(1);
        if ((++sp & 255u) == 0u) { if (xb_ld(&bar[XB_TMO])) break; if (sp > XB_SPIN_CAP) { atomicAdd(&bar[XB_TMO], 1u); break; } }
    }
    nloc = mine > 0u ? mine : 1u; nx = cnt > 0u ? cnt : 1u;
}
__device__ __forceinline__ void xcd_barrier(const XcdBarrier& b) {
    asm volatile("s_waitcnt vmcnt(0)" ::: "memory");
    __syncthreads();
    if (threadIdx.x == 0) {
        unsigned* bar = b.bar;
        __builtin_amdgcn_s_waitcnt(0);
        unsigned nloc = b.st[0], nx = b.st[1];
        if (nloc == 0u) { xcd_barrier_complete(bar, b.x, nloc, nx); b.st[0] = nloc; b.st[1] = nx; }
        const unsigned old = xb_add(&bar[XB_XSUB(b.x)], 1u);
        const unsigned gen = old / nloc;
        if (old + 1u == (gen + 1u) * nloc) {
            __builtin_amdgcn_fence(__ATOMIC_RELEASE, "agent");
            asm volatile("s_waitcnt vmcnt(0)" ::: "memory");
            const unsigned og = xb_add(&bar[XB_TOP], 1u);
            const unsigned tg = og / nx;
            if (og + 1u == (tg + 1u) * nx) xb_add(&bar[XB_TOPGEN], 1u);
            else XB_SPIN(xb_ld(&bar[XB_TOPGEN]) == tg, bar);
            __builtin_amdgcn_fence(__ATOMIC_ACQUIRE, "agent");
            xb_add(&bar[XB_XGEN(b.x)], 1u);
            asm volatile("s_waitcnt vmcnt(0)" ::: "memory");
        } else {
            XB_SPIN(xb_ld(&bar[XB_XGEN(b.x)]) == gen, bar);
            __builtin_amdgcn_fence(__ATOMIC_ACQUIRE, "agent");
            asm volatile("s_waitcnt vmcnt(0)" ::: "memory");
        }
    }
    __syncthreads();
}

namespace pg8 {
constexpr int BM = 256, BK = 64, HALF = 128, HTB = HALF * BK * 2, STAGE_BYTES = 8 * HTB, NXCD = 8, WGM = 8;
__host__ __device__ __forceinline__ int lds_byte(int r, int c) { const int st = (r >> 4) * 2 + (c >> 5), rr = r & 15, cc = c & 31, ob = rr * 64 + cc * 2; return st * 1024 + (ob ^ (((ob >> 9) & 1) << 5)); }
__host__ __device__ __forceinline__ void stage_rc(int b, int& R, int& C) { const int st = b / 1024, sb = b % 1024, swz = sb ^ (((sb >> 9) & 1) << 5); R = (st >> 1) * 16 + swz / 64; C = (st & 1) * 32 + (swz % 64) / 2; }
__host__ __device__ __forceinline__ int perm32(int rho) { const int n = rho >> 4, i = rho & 15; return 8 * (i >> 2) + 4 * n + (i & 3); }
struct Unit { int pm, pn; };
struct Gemm { const bf16_t* A; const bf16_t* Bt; int M, N, K, lda; };
struct StaticOrder {
    int nM, nN, nwg, G, c;
    __device__ void init(int M, int N, int G_, int c_) { nM = M / BM; nN = N / BM; nwg = nM * nN; G = G_; c = c_; }
    __device__ bool next(int i, Unit& u) const {
        const long L = (long)i * G + c; if (L >= nwg) return false;
        int wgid = (int)L; { const int q = nwg / NXCD, r = nwg % NXCD, xcd = wgid % NXCD, off = wgid / NXCD; wgid = (xcd < r ? xcd * (q + 1) : r * (q + 1) + (xcd - r) * q) + off; }
        const int nig = WGM * nN, gid = wgid / nig, fm = gid * WGM, gsz = (nM - fm) < WGM ? (nM - fm) : WGM;
        u.pm = fm + ((wgid % nig) % gsz); u.pn = (wgid % nig) / gsz; return true;
    }
};
template <class Epi>
__device__ __forceinline__ void gemm_phase(LAS unsigned char* lds, const Gemm g, const StaticOrder& S, const Epi& E) {
    int tid_ = threadIdx.x; asm volatile("" : "+v"(tid_));
    const int tid = tid_, wid = __builtin_amdgcn_readfirstlane(tid >> 6), lane = tid & 63, wr = wid >> 2, wc = wid & 3, fr = lane & 15, fq = lane >> 4;
    const int K = g.K, nt = K / BK, lda = g.lda;
    unsigned voffA[2], voffB[2];
#pragma unroll
    for (int i = 0; i < 2; ++i) { int R, C; stage_rc(tid * 16 + i * 8192, R, C); const int Rb = (R & ~31) + perm32(R & 31);
        voffA[i] = (unsigned)(R * lda + C) * 2u; voffB[i] = (unsigned)(Rb * K + C) * 2u; }
    const size_t kstep = (size_t)(BK * 2);
    const size_t hsA = (size_t)HALF * lda * 2, hsB = (size_t)HALF * K * 2;
    const size_t tsA = 2 * hsA, tsB = 2 * hsB;
    const unsigned ldsw = (unsigned)wid * 1024u;
    const int aoff = lds_byte(wr * 64 + fr, fq * 8), boff = lds_byte(wc * 32 + fr, fq * 8);
#define PG8_SA(b, h) (((b) * 2 + (h)) * HTB)
#define PG8_SB(b, h) ((4 + (b) * 2 + (h)) * HTB)
#define PG8_STAGE(bufoff, gbase, voff) do { _Pragma("unroll") for (int _i = 0; _i < 2; ++_i) \
        __builtin_amdgcn_global_load_lds((const unsigned*)((const char*)(gbase) + (voff)[_i]), (LAS unsigned*)(lds + (bufoff) + ldsw + _i * 8192), 16, 0, 0); } while (0)
#define PG8_LDA(dst, b, h) do { _Pragma("unroll") for (int m = 0; m < 4; ++m) _Pragma("unroll") for (int k = 0; k < 2; ++k) dst[m][k] = *(const LAS bf16x8*)(lds + PG8_SA(b, h) + aoff + m * 2048 + k * 1024); } while (0)
#define PG8_LDB(dst, b, h) do { _Pragma("unroll") for (int n = 0; n < 2; ++n) _Pragma("unroll") for (int k = 0; k < 2; ++k) dst[n][k] = *(const LAS bf16x8*)(lds + PG8_SB(b, h) + boff + n * 2048 + k * 1024); } while (0)
#define PG8_MMA(ai, bj, At, Bt) do { __builtin_amdgcn_s_setprio(1); _Pragma("unroll") for (int m = 0; m < 4; ++m) _Pragma("unroll") for (int n = 0; n < 2; ++n) _Pragma("unroll") for (int k = 0; k < 2; ++k) \
        acc[ai][bj][m][n] = __builtin_amdgcn_mfma_f32_16x16x32_bf16(Bt[n][k], At[m][k], acc[ai][bj][m][n], 0, 0, 0); __builtin_amdgcn_s_setprio(0); } while (0)
#define PG8_WAIT_V(n) asm volatile("s_waitcnt vmcnt(" #n ")" ::: "memory")
#define PG8_WAIT_L(n) asm volatile("s_waitcnt lgkmcnt(" #n ")" ::: "memory")
#define PG8_BAR __builtin_amdgcn_s_barrier()
#define PG8_SCHED __builtin_amdgcn_sched_barrier(0)
    Unit cur, nxt; int ui = 0;
    if (!S.next(0, cur)) return;
    f32x4 acc[2][2][4][2];
#pragma unroll
    for (int a = 0; a < 2; ++a)
#pragma unroll
        for (int b = 0; b < 2; ++b)
#pragma unroll
            for (int m = 0; m < 4; ++m)
#pragma unroll
                for (int n = 0; n < 2; ++n) acc[a][b][m][n] = (f32x4){0.f, 0.f, 0.f, 0.f};
    bf16x8 At[4][2], B0[2][2], B1[2][2];
    float pre[8];
#pragma unroll
    for (int i = 0; i < 8; ++i) pre[i] = 0.f;
    const char* cA = (const char*)g.A + (size_t)cur.pm * tsA; const char* cB = (const char*)g.Bt + (size_t)cur.pn * tsB;
    PG8_STAGE(PG8_SB(0, 0), cB, voffB); PG8_STAGE(PG8_SB(0, 1), cB + hsB, voffB); PG8_STAGE(PG8_SA(0, 0), cA, voffA); PG8_STAGE(PG8_SA(0, 1), cA + hsA, voffA);
    if (wr == 1) PG8_BAR;
    PG8_WAIT_V(2); PG8_BAR;
    PG8_STAGE(PG8_SB(1, 0), cB + kstep, voffB); PG8_STAGE(PG8_SA(1, 0), cA + kstep, voffA); PG8_STAGE(PG8_SB(1, 1), cB + hsB + kstep, voffB);
    PG8_WAIT_V(6); PG8_BAR;
    for (;;) {
        const bool has_next = S.next(ui + 1, nxt);
        const char* nA = has_next ? (const char*)g.A + (size_t)nxt.pm * tsA : cA; const char* nB = has_next ? (const char*)g.Bt + (size_t)nxt.pn * tsB : cB;
        for (int t = 0; t < nt; t += 2) {
            const bool last = (t == nt - 2);
            const char* a1 = cA + (size_t)(t + 1) * kstep;
            const char* a2 = last ? nA : cA + (size_t)(t + 2) * kstep; const char* b2 = last ? nB : cB + (size_t)(t + 2) * kstep;
            const char* a3 = a2 + kstep; const char* b3 = b2 + kstep;
            if constexpr (Epi::MID) { if (t == 8) E.mid(acc, cur, wr, wc, fr, fq); }
            if constexpr (Epi::PRE) { if (last) E.prefetch(pre, cur, wr, fr); }
            PG8_LDB(B0, 0, 0); PG8_LDB(B1, 0, 1); PG8_SCHED; PG8_LDA(At, 0, 0); PG8_STAGE(PG8_SA(1, 1), a1 + hsA, voffA);
            PG8_WAIT_V(8); PG8_WAIT_L(0); PG8_BAR; PG8_MMA(0, 0, At, B0); PG8_MMA(0, 1, At, B1); PG8_BAR; PG8_SCHED;
            PG8_LDA(At, 0, 1); PG8_STAGE(PG8_SB(0, 0), b2, voffB); PG8_STAGE(PG8_SB(0, 1), b2 + hsB, voffB); PG8_STAGE(PG8_SA(0, 0), a2, voffA);
            PG8_WAIT_V(8); PG8_WAIT_L(0); PG8_BAR; PG8_MMA(1, 0, At, B0); PG8_MMA(1, 1, At, B1); PG8_BAR; PG8_SCHED;
            PG8_LDB(B0, 1, 0); PG8_LDB(B1, 1, 1); PG8_SCHED; PG8_LDA(At, 1, 0); PG8_STAGE(PG8_SA(0, 1), a2 + hsA, voffA);
            PG8_WAIT_V(8); PG8_WAIT_L(0); PG8_BAR; PG8_MMA(0, 0, At, B0); PG8_MMA(0, 1, At, B1); PG8_BAR; PG8_SCHED;
            PG8_LDA(At, 1, 1); PG8_STAGE(PG8_SB(1, 0), b3, voffB); PG8_STAGE(PG8_SB(1, 1), b3 + hsB, voffB); PG8_STAGE(PG8_SA(1, 0), a3, voffA);
            PG8_WAIT_V(8); PG8_WAIT_L(0); PG8_BAR; PG8_MMA(1, 0, At, B0); PG8_MMA(1, 1, At, B1); PG8_BAR; PG8_SCHED;
        }
        if (wr == 0) PG8_BAR;
        E(acc, cur, wr, wc, fr, fq, pre);
        if (!has_next) break;
#pragma unroll
        for (int a = 0; a < 2; ++a)
#pragma unroll
            for (int b = 0; b < 2; ++b)
#pragma unroll
                for (int m = 0; m < 4; ++m)
#pragma unroll
                    for (int n = 0; n < 2; ++n) acc[a][b][m][n] = (f32x4){0.f, 0.f, 0.f, 0.f};
        cur = nxt; cA = nA; cB = nB; ++ui;
        if (wr == 1) PG8_BAR;
    }
    PG8_WAIT_V(0);
    PG8_BAR;
#undef PG8_SA
#undef PG8_SB
#undef PG8_STAGE
#undef PG8_LDA
#undef PG8_LDB
#undef PG8_MMA
#undef PG8_WAIT_V
#undef PG8_WAIT_L
#undef PG8_BAR
#undef PG8_SCHED
}
}
using pg8::Unit;
typedef const f32x4 (&AccRef)[2][2][4][2];

__device__ __forceinline__ u32x4 pack8(const f32x4 a, const f32x4 b) { u32x4 w; w.x = cvt_pk_bf16(a[0], a[1]); w.y = cvt_pk_bf16(a[2], a[3]); w.z = cvt_pk_bf16(b[0], b[1]); w.w = cvt_pk_bf16(b[2], b[3]); return w; }

struct EpiUp {
    static constexpr bool MID = false, PRE = true;
    const u64* rowsq; bf16_t* act;
    __device__ __forceinline__ void prefetch(float (&pre)[8], const Unit& u, int wr, int fr) const {
        const int row0 = u.pm * 256 + wr * 64 + fr;
#pragma unroll
        for (int i = 0; i < 8; ++i) pre[i] = __uint_as_float(rq_lo(rowsq, row0 + (i >> 2) * 128 + (i & 3) * 16));
    }
    __device__ __forceinline__ void operator()(AccRef acc, const Unit& u, int wr, int wc, int fr, int fq, const float (&pre)[8]) const {
        int row0 = u.pm * 256 + wr * 64 + fr; asm volatile("" : "+v"(row0)); const int col0 = u.pn * 128 + wc * 32 + 8 * fq;
#pragma unroll
        for (int ai = 0; ai < 2; ++ai)
#pragma unroll
            for (int m = 0; m < 4; ++m) { const int r = row0 + ai * 128 + m * 16; const float rs = rsqrtf(rqlo2f(__float_as_uint(pre[ai * 4 + m])) * (1.0f / DM) + 1e-6f);
                const float k1 = -1.4426950408889634f * rs, rs2 = rs * rs;
                f32x4 o0, o1;
#pragma unroll
                for (int i = 0; i < 4; ++i) {
                    const float g0 = acc[ai][0][m][0][i], g1 = acc[ai][0][m][1][i];
                    o0[i] = (g0 * acc[ai][1][m][0][i]) * (rs2 * fast_rcp(1.0f + __builtin_amdgcn_exp2f(g0 * k1)));
                    o1[i] = (g1 * acc[ai][1][m][1][i]) * (rs2 * fast_rcp(1.0f + __builtin_amdgcn_exp2f(g1 * k1))); }
                *(u32x4*)(act + (size_t)r * FF + col0) = pack8(o0, o1); asm volatile("" ::: "memory"); }
    }
};
template <bool B16, bool W32>
struct EpiDown {
    static constexpr bool MID = false, PRE = false;
    const float* base; float* out; bf16_t* hb; u64* rowsq_out; float scale;
    __device__ __forceinline__ void operator()(AccRef acc, const Unit& u, int wr, int wc, int fr, int fq, const float (&pre)[8]) const {
        int row0 = u.pm * 256 + wr * 64 + fr; asm volatile("" : "+v"(row0)); const int col0 = u.pn * 256 + wc * 32 + 8 * fq;
#pragma unroll
        for (int ai = 0; ai < 2; ++ai)
#pragma unroll
            for (int mp = 0; mp < 2; ++mp) {
                f32x4 b[2][2][2];
#pragma unroll
                for (int q = 0; q < 2; ++q) { const int r = row0 + ai * 128 + (2 * mp + q) * 16;
#pragma unroll
                    for (int bj = 0; bj < 2; ++bj) { const int c = col0 + bj * 128;
                        if constexpr (B16) { const u32x4 w = *(const u32x4*)(hb + (size_t)r * DM + c); b[q][bj][0] = (f32x4){bflo(w.x), bfhi(w.x), bflo(w.y), bfhi(w.y)}; b[q][bj][1] = (f32x4){bflo(w.z), bfhi(w.z), bflo(w.w), bfhi(w.w)}; }
                        else { const float* bp = base + (size_t)r * DM + c; b[q][bj][0] = *(const f32x4*)bp; b[q][bj][1] = *(const f32x4*)(bp + 4); } } }
#pragma unroll
                for (int q = 0; q < 2; ++q) { const int m = 2 * mp + q, r = row0 + ai * 128 + m * 16; float ss = 0.f;
#pragma unroll
                    for (int bj = 0; bj < 2; ++bj) { const int c = col0 + bj * 128;
                        const f32x4 v0 = b[q][bj][0] + scale * acc[ai][bj][m][0], v1 = b[q][bj][1] + scale * acc[ai][bj][m][1];
                        if constexpr (W32) { float* op = out + (size_t)r * DM + c; *(f32x4*)op = v0; *(f32x4*)(op + 4) = v1; }
                        *(u32x4*)(hb + (size_t)r * DM + c) = pack8(v0, v1);
                        ss += (v0[0] * v0[0] + v0[1] * v0[1]) + (v0[2] * v0[2] + v0[3] * v0[3]) + (v1[0] * v1[0] + v1[1] * v1[1]) + (v1[2] * v1[2] + v1[3] * v1[3]); }
                    ss += __shfl_xor(ss, 16); ss += __shfl_xor(ss, 32);
                    if (fq == 0) atomicAdd(rowsq_out + r, f2rq(ss)); }
                asm volatile("" ::: "memory"); }
    }
};
struct EpiFinal {
    static constexpr bool MID = false, PRE = false;
    float* out; const bf16_t* hb; u64* rowsq; unsigned* cnt; const float* gfin;
    __device__ __forceinline__ void operator()(AccRef acc, const Unit& u, int wr, int wc, int fr, int fq, const float (&pre)[8]) const {
        int row0 = u.pm * 256 + wr * 64 + fr; asm volatile("" : "+v"(row0)); const int col0 = u.pn * 256 + wc * 32 + 8 * fq;
#pragma unroll
        for (int ai = 0; ai < 2; ++ai)
#pragma unroll
            for (int mp = 0; mp < 2; ++mp) {
                u32x4 w[2][2];
#pragma unroll
                for (int q = 0; q < 2; ++q)
#pragma unroll
                    for (int bj = 0; bj < 2; ++bj) w[q][bj] = *(const u32x4*)(hb + (size_t)(row0 + ai * 128 + (2 * mp + q) * 16) * DM + col0 + bj * 128);
#pragma unroll
                for (int q = 0; q < 2; ++q) { const int m = 2 * mp + q, r = row0 + ai * 128 + m * 16; float ss = 0.f;
#pragma unroll
                    for (int bj = 0; bj < 2; ++bj) { const u32x4 x = w[q][bj];
                        const f32x4 v0 = (f32x4){bflo(x.x), bfhi(x.x), bflo(x.y), bfhi(x.y)} + 0.5f * acc[ai][bj][m][0], v1 = (f32x4){bflo(x.z), bfhi(x.z), bflo(x.w), bfhi(x.w)} + 0.5f * acc[ai][bj][m][1];
                        ss += (v0[0] * v0[0] + v0[1] * v0[1]) + (v0[2] * v0[2] + v0[3] * v0[3]) + (v1[0] * v1[0] + v1[1] * v1[1]) + (v1[2] * v1[2] + v1[3] * v1[3]); }
                    ss += __shfl_xor(ss, 16); ss += __shfl_xor(ss, 32);
                    if (fq == 0) atomicAdd(rowsq + r, f2rq(ss)); }
                asm volatile("" ::: "memory"); }
        asm volatile("s_waitcnt vmcnt(0)" ::: "memory");
        unsigned* cw = cnt + 64 * u.pm;
        if ((threadIdx.x & 63) == 0) __hip_atomic_fetch_add(cw, 1u, __ATOMIC_RELAXED, __HIP_MEMORY_SCOPE_AGENT);
        { unsigned sp = 0;
          while ((unsigned)__builtin_amdgcn_readfirstlane(__hip_atomic_load(cw, __ATOMIC_RELAXED, __HIP_MEMORY_SCOPE_AGENT)) < 32u) { __builtin_amdgcn_s_sleep(2); if (++sp > (1u << 22)) break; } }
        f32x4 gv[2][2];
#pragma unroll
        for (int bj = 0; bj < 2; ++bj) { gv[bj][0] = *(const f32x4*)(gfin + col0 + bj * 128); gv[bj][1] = *(const f32x4*)(gfin + col0 + bj * 128 + 4); }
        u64 rqv[8];
#pragma unroll
        for (int i = 0; i < 8; ++i) rqv[i] = __hip_atomic_load(rowsq + row0 + (i >> 2) * 128 + (i & 3) * 16, __ATOMIC_RELAXED, __HIP_MEMORY_SCOPE_AGENT);
#pragma unroll
        for (int ai = 0; ai < 2; ++ai)
#pragma unroll
            for (int mp = 0; mp < 2; ++mp) {
                u32x4 w[2][2];
#pragma unroll
                for (int q = 0; q < 2; ++q)
#pragma unroll
                    for (int bj = 0; bj < 2; ++bj) w[q][bj] = *(const u32x4*)(hb + (size_t)(row0 + ai * 128 + (2 * mp + q) * 16) * DM + col0 + bj * 128);
#pragma unroll
                for (int q = 0; q < 2; ++q) { const int m = 2 * mp + q, r = row0 + ai * 128 + m * 16; float* op = out + (size_t)r * DM;
                    const float rs = rsqrtf(rq2f(rqv[ai * 4 + m]) * (1.0f / DM) + 1e-6f);
#pragma unroll
                    for (int bj = 0; bj < 2; ++bj) { const int c = col0 + bj * 128; const u32x4 x = w[q][bj];
                        const f32x4 v0 = (f32x4){bflo(x.x), bfhi(x.x), bflo(x.y), bfhi(x.y)} + 0.5f * acc[ai][bj][m][0], v1 = (f32x4){bflo(x.z), bfhi(x.z), bflo(x.w), bfhi(x.w)} + 0.5f * acc[ai][bj][m][1];
                        *(f32x4*)(op + c) = v0 * rs * gv[bj][0]; *(f32x4*)(op + c + 4) = v1 * rs * gv[bj][1]; } }
                asm volatile("" ::: "memory"); }
    }
};
struct EpiIn {
    static constexpr bool MID = false, PRE = false;
    const u64* rowsq; bf16_t* z; const float* tab;
    __device__ __forceinline__ void prefetch(float (&pre)[8], const Unit& u, int wr, int fr) const {
        const int row0 = u.pm * 256 + wr * 64 + fr;
#pragma unroll
        for (int i = 0; i < 8; ++i) pre[i] = __uint_as_float(rq_lo(rowsq, row0 + (i >> 2) * 128 + (i & 3) * 16));
    }
    __device__ __forceinline__ void operator()(AccRef acc, const Unit& u, int wr, int wc, int fr, int fq, const float (&pre)[8]) const {
        int row0 = u.pm * 256 + wr * 64 + fr; asm volatile("" : "+v"(row0));
        unsigned rq[8];
#pragma unroll
        for (int i = 0; i < 8; ++i) rq[i] = rq_lo(rowsq, row0 + (i >> 2) * 128 + (i & 3) * 16);
        if (u.pn < 4) {
            const bool isq = u.pn < 2; const int hh = wc >> 1, head = (u.pn & 1) * 2 + hh, j0 = 32 * (wc & 1) + 8 * fq;
            const float lg = log2_gamma(head);
#pragma unroll
            for (int ai = 0; ai < 2; ++ai)
#pragma unroll
                for (int mp = 0; mp < 2; ++mp) {
                    f32x4 t[2][4];
#pragma unroll
                    for (int q = 0; q < 2; ++q) { const int r = row0 + ai * 128 + (2 * mp + q) * 16; const int pos = (r & (SEQ - 1)) + NMETA; const f32x4* tp = (const f32x4*)(tab + ((size_t)pos * 64 + j0) * 2);
#pragma unroll
                        for (int k = 0; k < 4; ++k) t[q][k] = tp[k]; }
#pragma unroll
                    for (int q = 0; q < 2; ++q) { const int m = 2 * mp + q, r = row0 + ai * 128 + m * 16; const float rs = rsqrtf(rqlo2f(rq[ai * 4 + m]) * (1.0f / DM) + 1e-6f);
                        const int cidx = (r & (SEQ - 1)) & 127;
                        const float f = rs * (isq ? 0.08838834764831845f * exp2f((float)cidx * lg) : exp2f(-(float)cidx * lg));
                        bf16_t* zp = z + (size_t)r * NIN + u.pn * 256 + hh * 128 + j0;
#pragma unroll
                        for (int n = 0; n < 2; ++n) { const f32x4 ta = t[q][2 * n], tb = t[q][2 * n + 1]; const f32x4 x1 = acc[ai][0][m][n], x2 = acc[ai][1][m][n];
                            u32x2 w1, w2;
                            w1.x = cvt_pk_bf16((x1[0] * ta[0] - x2[0] * ta[1]) * f, (x1[1] * ta[2] - x2[1] * ta[3]) * f); w1.y = cvt_pk_bf16((x1[2] * tb[0] - x2[2] * tb[1]) * f, (x1[3] * tb[2] - x2[3] * tb[3]) * f);
                            w2.x = cvt_pk_bf16((x1[0] * ta[1] + x2[0] * ta[0]) * f, (x1[1] * ta[3] + x2[1] * ta[2]) * f); w2.y = cvt_pk_bf16((x1[2] * tb[1] + x2[2] * tb[0]) * f, (x1[3] * tb[3] + x2[3] * tb[2]) * f);
                            *(u32x2*)(zp + 4 * n) = w1; *(u32x2*)(zp + 64 + 4 * n) = w2; } }
                    asm volatile("" ::: "memory"); }
        } else {
            const int col0 = u.pn * 256 + wc * 32 + 8 * fq;
#pragma unroll
            for (int ai = 0; ai < 2; ++ai)
#pragma unroll
                for (int m = 0; m < 4; ++m) { const int r = row0 + ai * 128 + m * 16; const float rs = rsqrtf(rqlo2f(rq[ai * 4 + m]) * (1.0f / DM) + 1e-6f);
#pragma unroll
                    for (int bj = 0; bj < 2; ++bj) *(u32x4*)(z + (size_t)r * NIN + col0 + bj * 128) = pack8(acc[ai][bj][m][0] * rs, acc[ai][bj][m][1] * rs); }
        }
    }
};
struct EpiMix {
    static constexpr bool MID = true, PRE = false;
    bf16_t* z;
    static __device__ __forceinline__ float cl(float x) { return fminf(fmaxf(x, -30.f), 30.f); }
    __device__ __forceinline__ void mid(f32x4 (&acc)[2][2][4][2], const Unit& u, int wr, int wc, int fr, int fq) const {
        int row0 = u.pm * 256 + wr * 64 + fr; const int col0 = u.pn * 256 + wc * 32 + 8 * fq;
        asm volatile("" : "+v"(row0));
#pragma unroll
        for (int ai = 0; ai < 2; ++ai)
#pragma unroll
            for (int mp = 0; mp < 2; ++mp) {
                u32x4 ga[2][2], gb[2][2];
#pragma unroll
                for (int q = 0; q < 2; ++q) { const int r = row0 + ai * 128 + (2 * mp + q) * 16;
#pragma unroll
                    for (int bj = 0; bj < 2; ++bj) { const bf16_t* gp = z + (size_t)r * NIN + 2560 + col0 + bj * 128; ga[q][bj] = *(const u32x4*)gp; gb[q][bj] = *(const u32x4*)(gp + 1024); } }
#pragma unroll
                for (int q = 0; q < 2; ++q) { const int m = 2 * mp + q;
#pragma unroll
                    for (int bj = 0; bj < 2; ++bj)
#pragma unroll
                        for (int i = 0; i < 4; ++i) { const unsigned wa = ga[q][bj][i], wb = gb[q][bj][i];
                            const float r0 = (1.0f + expneg(cl(bflo(wb)))) * fast_rcp(1.0f + expneg(cl(bflo(wa))));
                            const float r1 = (1.0f + expneg(cl(bfhi(wb)))) * fast_rcp(1.0f + expneg(cl(bfhi(wa))));
                            acc[ai][bj][m][i >> 1][(i & 1) * 2] *= r0; acc[ai][bj][m][i >> 1][(i & 1) * 2 + 1] *= r1; } }
                asm volatile("" ::: "memory"); }
    }
    __device__ __forceinline__ void operator()(AccRef acc, const Unit& u, int wr, int wc, int fr, int fq, const float (&pre)[8]) const {
        const int row0 = u.pm * 256 + wr * 64 + fr, col0 = u.pn * 256 + wc * 32 + 8 * fq;
#pragma unroll
        for (int ai = 0; ai < 2; ++ai) {
            u32x4 gb[4][2];
#pragma unroll
            for (int m = 0; m < 4; ++m)
#pragma unroll
                for (int bj = 0; bj < 2; ++bj) gb[m][bj] = *(const u32x4*)(z + (size_t)(row0 + ai * 128 + m * 16) * NIN + 3584 + col0 + bj * 128);
#pragma unroll
            for (int m = 0; m < 4; ++m) { const int r = row0 + ai * 128 + m * 16;
#pragma unroll
                for (int bj = 0; bj < 2; ++bj) { const u32x4 g = gb[m][bj]; f32x4 o0, o1;
                    o0[0] = acc[ai][bj][m][0][0] * fast_rcp(1.0f + expneg(cl(bflo(g[0])))); o0[1] = acc[ai][bj][m][0][1] * fast_rcp(1.0f + expneg(cl(bfhi(g[0]))));
                    o0[2] = acc[ai][bj][m][0][2] * fast_rcp(1.0f + expneg(cl(bflo(g[1])))); o0[3] = acc[ai][bj][m][0][3] * fast_rcp(1.0f + expneg(cl(bfhi(g[1]))));
                    o1[0] = acc[ai][bj][m][1][0] * fast_rcp(1.0f + expneg(cl(bflo(g[2])))); o1[1] = acc[ai][bj][m][1][1] * fast_rcp(1.0f + expneg(cl(bfhi(g[2]))));
                    o1[2] = acc[ai][bj][m][1][2] * fast_rcp(1.0f + expneg(cl(bflo(g[3])))); o1[3] = acc[ai][bj][m][1][3] * fast_rcp(1.0f + expneg(cl(bfhi(g[3]))));
                    *(u32x4*)(z + (size_t)r * NIN + 1024 + col0 + bj * 128) = pack8(o0, o1); } }
            asm volatile("" ::: "memory"); }
    }
};

struct SkArgs { const bf16_t* A; int lda; const bf16_t* Bt; int K; const u64* rowsq_in; u64* rowsq_out; float* hmeta; bf16_t* hb; bf16_t* z; const float* tab; float scale; };
template <int MODE>
__device__ __forceinline__ void skinny(LAS unsigned char* lds, const SkArgs a) {
    int tid_ = threadIdx.x; asm volatile("" : "+v"(tid_));
    const int tid = tid_, lane = tid & 63, wave = __builtin_amdgcn_readfirstlane(tid >> 6), l15 = lane & 15, g = lane >> 4;
    constexpr int NITEMS = MODE == 0 ? 176 : (MODE == 2 ? 256 : 64);
    const int K = a.K;
    LAS f32x4* red = (LAS f32x4*)lds;
    for (int it = blockIdx.x; it < NITEMS; it += gridDim.x) {
        int brow0 = 16 * it, brow1 = 0; bool pair = false;
        if (MODE == 0) { const int hid = 16 * it; brow0 = ((hid >> 7) << 8) + (hid & 127); brow1 = brow0 + 128; pair = true; }
        if (MODE == 2) { if (it < 32) { brow0 = ((it >> 3) << 8) + (((it >> 2) & 1) << 6) + 16 * (it & 3); brow1 = brow0 + 128; pair = true; } else brow0 = 1024 + 16 * (it - 32); }
        int kb, ke;
        if (MODE == 3) { kb = (wave >> 2) * 512 + (wave & 3) * 128; ke = kb + 128; } else { const int kper = K >> 3; kb = wave * kper; ke = kb + kper; }
        f32x4 acc0 = (f32x4){0.f, 0.f, 0.f, 0.f}, acc1 = (f32x4){0.f, 0.f, 0.f, 0.f};
        const bf16_t* ap = a.A + (size_t)l15 * a.lda + 8 * g;
        const bf16_t* bp0 = a.Bt + (size_t)(brow0 + l15) * K + 8 * g;
        const bf16_t* bp1 = a.Bt + (size_t)(brow1 + l15) * K + 8 * g;
#pragma unroll 4
        for (int k = kb; k < ke; k += 32) { const bf16x8 av = *(const bf16x8*)(ap + k);
            acc0 = __builtin_amdgcn_mfma_f32_16x16x32_bf16(av, *(const bf16x8*)(bp0 + k), acc0, 0, 0, 0);
            if (pair) acc1 = __builtin_amdgcn_mfma_f32_16x16x32_bf16(av, *(const bf16x8*)(bp1 + k), acc1, 0, 0, 0); }
        red[(wave * 2 + 0) * 64 + lane] = acc0; red[(wave * 2 + 1) * 64 + lane] = acc1;
        __syncthreads();
        if (wave == 0) {
            f32x4 v0 = (f32x4){0.f, 0.f, 0.f, 0.f}, v1 = (f32x4){0.f, 0.f, 0.f, 0.f};
            if (MODE == 3) { for (int w = 0; w < 4; ++w) { v0 += red[(w * 2) * 64 + lane]; v1 += red[((w + 4) * 2) * 64 + lane]; } }
            else { for (int w = 0; w < 8; ++w) { v0 += red[(w * 2) * 64 + lane]; v1 += red[(w * 2 + 1) * 64 + lane]; } }
#pragma unroll
            for (int r = 0; r < 4; ++r) { const int row = 4 * g + r; const size_t R = (size_t)(TS + row);
                if (MODE == 0) { const float rs = rsqrtf(rq2f(a.rowsq_in[TS + row]) * (1.0f / DM) + 1e-6f);
                    a.z[R * FF + 16 * it + l15] = (bf16_t)(cvt_pk_bf16(silu_f(v0[r] * rs) * (v1[r] * rs), 0.f) & 0xffffu); }
                if (MODE == 1) { const int col = 16 * it + l15; const float hn = a.hmeta[(size_t)row * DM + col] + a.scale * v0[r];
                    a.hmeta[(size_t)row * DM + col] = hn; a.hb[R * DM + col] = (bf16_t)(cvt_pk_bf16(hn, 0.f) & 0xffffu);
                    float ss = hn * hn; ss += __shfl_xor(ss, 1); ss += __shfl_xor(ss, 2); ss += __shfl_xor(ss, 4); ss += __shfl_xor(ss, 8);
                    if (l15 == 0) atomicAdd(a.rowsq_out + TS + row, f2rq(ss)); }
                if (MODE == 2) { const float rs = rsqrtf(rq2f(a.rowsq_in[TS + row]) * (1.0f / DM) + 1e-6f);
                    if (it < 32) { const int pn = it >> 3, hh = (it >> 2) & 1, j = 16 * (it & 3) + l15, head = (pn & 1) * 2 + hh; const float lg = log2_gamma(head); const float cidx = (float)(112 + row);
                        const float f = rs * (pn < 2 ? 0.08838834764831845f * exp2f(cidx * lg) : exp2f(-cidx * lg));
                        const float c = a.tab[((size_t)row * 64 + j) * 2], sn = a.tab[((size_t)row * 64 + j) * 2 + 1];
                        bf16_t* zp = a.z + R * NIN + pn * 256 + hh * 128 + j;
                        zp[0] = (bf16_t)(cvt_pk_bf16((v0[r] * c - v1[r] * sn) * f, 0.f) & 0xffffu); zp[64] = (bf16_t)(cvt_pk_bf16((v0[r] * sn + v1[r] * c) * f, 0.f) & 0xffffu); }
                    else a.z[R * NIN + brow0 + l15] = (bf16_t)(cvt_pk_bf16(v0[r] * rs, 0.f) & 0xffffu); }
                if (MODE == 3) { const int col = 16 * it + l15; const float ga = bf2f(a.z[R * NIN + 2560 + col]), gb = bf2f(a.z[R * NIN + 3584 + col]);
                    const float mx = v0[r] * fast_rcp(1.0f + expneg(ga)) + v1[r] * fast_rcp(1.0f + expneg(gb));
                    a.z[R * NIN + 1024 + col] = (bf16_t)(cvt_pk_bf16(mx, 0.f) & 0xffffu); } }
        }
        __syncthreads();
    }
}

__device__ __forceinline__ int maprow(int map, int n) {
    if (map == 1) return ((n >> 7) << 8) + (n & 127);
    if (map == 2) return ((n >> 7) << 8) + 128 + (n & 127);
    if (map == 3) { if (n >= 1024) return n; const int pn = n >> 8, hh = (n >> 7) & 1, half = (n >> 6) & 1, j = n & 63; return (pn << 8) + (half << 7) + (hh << 6) + j; }
    return n;
}
__device__ __forceinline__ void conv_item(const float* src, int N, const float* gain, bf16_t* dst, int ldd, int koff, int map, int item, LAS float* scr, int lane) {
    const int nblk = N / 32, kb = item / nblk, nb = item % nblk, k0 = 64 * kb, n0 = 32 * nb;
    { f32x4 v[8]; const int kr = lane >> 3, n4 = lane & 7;
#pragma unroll
      for (int i = 0; i < 8; ++i) v[i] = *(const f32x4*)(src + (size_t)(k0 + 8 * i + kr) * N + n0 + 4 * n4);
#pragma unroll
      for (int i = 0; i < 8; ++i) { const int kk = 8 * i + kr; const float gg = gain ? gain[k0 + kk] : 1.0f; LAS float* d = scr + kk * 33 + 4 * n4;
          d[0] = v[i][0] * gg; d[1] = v[i][1] * gg; d[2] = v[i][2] * gg; d[3] = v[i][3] * gg; } }
    asm volatile("s_waitcnt lgkmcnt(0)" ::: "memory");
    const int c = lane & 7;
#pragma unroll
    for (int j = 0; j < 4; ++j) { const int n = (lane >> 3) + 8 * j; const LAS float* s = scr + (8 * c) * 33 + n;
        u32x4 o; o.x = cvt_pk_bf16(s[0 * 33], s[1 * 33]); o.y = cvt_pk_bf16(s[2 * 33], s[3 * 33]); o.z = cvt_pk_bf16(s[4 * 33], s[5 * 33]); o.w = cvt_pk_bf16(s[6 * 33], s[7 * 33]);
        *(u32x4*)(dst + (size_t)maprow(map, n0 + n) * ldd + koff + k0 + 8 * c) = o; }
    asm volatile("s_waitcnt lgkmcnt(0)" ::: "memory");
}
__device__ __forceinline__ void weff_item(const float* maps, const float* scale, const float* wp, bf16_t* dst, int item, int lane) {
    const int ab = item >> 4, nb = item & 15, i0 = 16 * ab, g = i0 >> 7, a0 = i0 & 127, n = 64 * nb + lane;
    const float* mp = maps + ((size_t)g * 128 + a0) * 128; const float* sc = scale + g * 128; const float* wc = wp + (size_t)(g * 128) * DM + n;
    float s[16];
#pragma unroll
    for (int a = 0; a < 16; ++a) s[a] = 0.f;
    for (int j = 0; j < 128; j += 4) {
        const float w0 = sc[j] * wc[(size_t)j * DM], w1 = sc[j + 1] * wc[(size_t)(j + 1) * DM], w2 = sc[j + 2] * wc[(size_t)(j + 2) * DM], w3 = sc[j + 3] * wc[(size_t)(j + 3) * DM];
#pragma unroll
        for (int a = 0; a < 16; ++a) { const float* m = mp + a * 128 + j; s[a] += m[0] * w0 + m[1] * w1 + m[2] * w2 + m[3] * w3; }
    }
    u32x4 o0, o1;
    o0.x = cvt_pk_bf16(s[0], s[1]); o0.y = cvt_pk_bf16(s[2], s[3]); o0.z = cvt_pk_bf16(s[4], s[5]); o0.w = cvt_pk_bf16(s[6], s[7]);
    o1.x = cvt_pk_bf16(s[8], s[9]); o1.y = cvt_pk_bf16(s[10], s[11]); o1.z = cvt_pk_bf16(s[12], s[13]); o1.w = cvt_pk_bf16(s[14], s[15]);
    bf16_t* d = dst + (size_t)n * DM + 512 + i0;
    *(u32x4*)d = o0; *(u32x4*)(d + 8) = o1;
}
__device__ __forceinline__ void row_to_bf16(const float* xrow, bf16_t* hbrow, float* hmrow, u64* rsq, int lane, bool zero) {
    f32x4 v[4]; float s = 0.f;
#pragma unroll
    for (int j = 0; j < 4; ++j) { v[j] = zero ? (f32x4){0.f, 0.f, 0.f, 0.f} : ((const f32x4*)xrow)[lane + 64 * j]; s += (v[j][0] * v[j][0] + v[j][1] * v[j][1]) + (v[j][2] * v[j][2] + v[j][3] * v[j][3]); }
    s = wave_sum(s);
#pragma unroll
    for (int j = 0; j < 4; ++j) { u32x2 w; w.x = cvt_pk_bf16(v[j][0], v[j][1]); w.y = cvt_pk_bf16(v[j][2], v[j][3]); ((u32x2*)hbrow)[lane + 64 * j] = w; if (hmrow) ((f32x4*)hmrow)[lane + 64 * j] = v[j]; }
    if (lane == 0) *rsq = f2rq(s);
}
__device__ __forceinline__ void phase_prep(const Params& P, LAS unsigned char* lds) {
    int tid_ = threadIdx.x; asm volatile("" : "+v"(tid_));
    const int tid = tid_, lane = tid & 63, wave = tid >> 6;
    const int gw = blockIdx.x * 8 + wave, NGW = gridDim.x * 8;
    LAS float* scr = (LAS float*)(lds + wave * 8448);
    unsigned char* ws = P.ws;
    constexpr int I_G = 16 * 88, I_D = 44 * 32, I_IN = 16 * 144, I_R = 8 * 32, I_O = 16 * 32;
    constexpr int PER_LAYER = 6 * I_G + I_IN + I_R + I_O;
    static_assert(I_G == I_D, "item counts");
    constexpr int NITEMS = 1024 + 2 * PER_LAYER;
    for (int it = gw; it < NITEMS; it += NGW) {
        if (it < 1024) { const int l = it >> 9, r = it & 511;
            weff_item(P.in[8] + (size_t)l * 4 * 128 * 128, P.in[9] + (size_t)l * 512, P.in[11] + (size_t)l * 512 * DM, (bf16_t*)(ws + WS_W + l * W_LAYER + W_WRP), r, lane); continue; }
        int r = it - 1024; const int l = r / PER_LAYER; r -= l * PER_LAYER;
        unsigned char* wl = ws + WS_W + l * W_LAYER;
        const float* n1 = P.in[2] + (size_t)l * DM; const float* nm = P.in[6] + (size_t)l * DM; const float* n2 = P.in[13] + (size_t)l * DM;
        if (r < I_G) { conv_item(P.in[3] + (size_t)l * DM * FF, FF, n1, (bf16_t*)(wl + W_W1), DM, 0, 1, r, scr, lane); continue; } r -= I_G;
        if (r < I_G) { conv_item(P.in[4] + (size_t)l * DM * FF, FF, n1, (bf16_t*)(wl + W_W1), DM, 0, 2, r, scr, lane); continue; } r -= I_G;
        if (r < I_D) { conv_item(P.in[5] + (size_t)l * FF * DM, DM, nullptr, (bf16_t*)(wl + W_W1D), FF, 0, 0, r, scr, lane); continue; } r -= I_D;
        if (r < I_IN) { conv_item(P.in[7] + (size_t)l * DM * NIN, NIN, nm, (bf16_t*)(wl + W_WIN), DM, 0, 3, r, scr, lane); continue; } r -= I_IN;
        if (r < I_R) { conv_item(P.in[10] + (size_t)l * 512 * DM, DM, nullptr, (bf16_t*)(wl + W_WRP), DM, 0, 0, r, scr, lane); continue; } r -= I_R;
        if (r < I_O) { conv_item(P.in[12] + (size_t)l * DM * DM, DM, nullptr, (bf16_t*)(wl + W_WO), DM, 0, 0, r, scr, lane); continue; } r -= I_O;
        if (r < I_G) { conv_item(P.in[14] + (size_t)l * DM * FF, FF, n2, (bf16_t*)(wl + W_W2), DM, 0, 1, r, scr, lane); continue; } r -= I_G;
        if (r < I_G) { conv_item(P.in[15] + (size_t)l * DM * FF, FF, n2, (bf16_t*)(wl + W_W2), DM, 0, 2, r, scr, lane); continue; } r -= I_G;
        conv_item(P.in[16] + (size_t)l * FF * DM, DM, nullptr, (bf16_t*)(wl + W_W2D), FF, 0, 0, r, scr, lane);
    }
    u64* rowsq = (u64*)(ws + WS_ROWSQ); bf16_t* hb = (bf16_t*)(ws + WS_HB); float* hmeta = (float*)(ws + WS_HMETA);
    for (int m = 2 * gw; m < TS; m += 2 * NGW) {
        const int m2 = m + 1; const f32x4* xa = (const f32x4*)(P.in[0] + (size_t)m * DM); const f32x4* xb = (const f32x4*)(P.in[0] + (size_t)m2 * DM);
        f32x4 va[4], vb[4]; float sa = 0.f, sb = 0.f;
#pragma unroll
        for (int j = 0; j < 4; ++j) { va[j] = xa[lane + 64 * j]; vb[j] = xb[lane + 64 * j]; }
#pragma unroll
        for (int j = 0; j < 4; ++j) { sa += (va[j][0] * va[j][0] + va[j][1] * va[j][1]) + (va[j][2] * va[j][2] + va[j][3] * va[j][3]); sb += (vb[j][0] * vb[j][0] + vb[j][1] * vb[j][1]) + (vb[j][2] * vb[j][2] + vb[j][3] * vb[j][3]); }
        sa = wave_sum(sa); sb = wave_sum(sb);
#pragma unroll
        for (int j = 0; j < 4; ++j) { u32x2 wa, wb; wa.x = cvt_pk_bf16(va[j][0], va[j][1]); wa.y = cvt_pk_bf16(va[j][2], va[j][3]); wb.x = cvt_pk_bf16(vb[j][0], vb[j][1]); wb.y = cvt_pk_bf16(vb[j][2], vb[j][3]);
            ((u32x2*)(hb + (size_t)m * DM))[lane + 64 * j] = wa; ((u32x2*)(hb + (size_t)m2 * DM))[lane + 64 * j] = wb; }
        if (lane == 0) { rowsq[m] = f2rq(sa); rowsq[m2] = f2rq(sb); } }
    for (int m = gw; m < NMETA; m += NGW) row_to_bf16(P.in[1] + (size_t)m * DM, hb + (size_t)(TS + m) * DM, hmeta + (size_t)m * DM, rowsq + TS + m, lane, false);
    const int gt = blockIdx.x * 512 + tid, NGT = gridDim.x * 512;
    for (int i = gt; i < 6 * TM; i += NGT) rowsq[TM + i] = 0ull;
    { unsigned* cnt = (unsigned*)(ws + WS_CNT); for (int i = gt; i < 128 * 64; i += NGT) cnt[i] = 0u; }
    float* tab = (float*)(ws + WS_TAB);
    for (int i = gt; i < NPOS * 64; i += NGT) { const int pos = i >> 6, j = i & 63;
        const double inv = exp2(-(double)j * (13.287712379549449 / 64.0)); const double ang = (double)pos * inv;
        const double k = rint(ang * 0.15915494309189535); const float rr = (float)(ang - k * 6.283185307179586);
        tab[2 * i] = cosf(rr); tab[2 * i + 1] = sinf(rr); }
}

__device__ __forceinline__ unsigned offb(unsigned row, unsigned ch) { return 256u * row + 16u * (ch ^ (((row & 3) << 2) | ((row >> 2) & 3))); }
__device__ __forceinline__ unsigned row_addr16(unsigned lane, unsigned rb, unsigned s) { return offb((lane & 15) + 16 * rb, 4 * s + (lane >> 4)); }
__device__ __forceinline__ unsigned tr_addr16(unsigned lane, unsigned c, unsigned ks, unsigned t) { const unsigned g = lane >> 4, q = (lane & 15) >> 2, p = lane & 3; return offb(32 * ks + 8 * g + 4 * t + q, 2 * c + (p >> 1)) + 8 * (p & 1); }
__device__ __forceinline__ bf16x8 tr_frag(unsigned tile, unsigned lane, unsigned c, unsigned ks) {
    u32x2 r0, r1; const unsigned a0 = tile + tr_addr16(lane, c, ks, 0), a1 = tile + tr_addr16(lane, c, ks, 1);
    asm volatile("ds_read_b64_tr_b16 %0, %2\n\tds_read_b64_tr_b16 %1, %3\n\ts_waitcnt lgkmcnt(0)" : "=&v"(r0), "=&v"(r1) : "v"(a0), "v"(a1) : "memory");
    u32x4 w; w.x = r0.x; w.y = r0.y; w.z = r1.x; w.w = r1.y; return __builtin_bit_cast(bf16x8, w);
}
__device__ __forceinline__ void tr_frag8(unsigned tile, unsigned lane, unsigned ks, bf16x8 (&f)[8]) {
    u32x2 r[16]; unsigned a[16];
#pragma unroll
    for (int c = 0; c < 8; ++c) { a[2 * c] = tile + tr_addr16(lane, c, ks, 0); a[2 * c + 1] = tile + tr_addr16(lane, c, ks, 1); }
    asm volatile("ds_read_b64_tr_b16 %0, %16\n\tds_read_b64_tr_b16 %1, %17\n\tds_read_b64_tr_b16 %2, %18\n\tds_read_b64_tr_b16 %3, %19\n\t"
                 "ds_read_b64_tr_b16 %4, %20\n\tds_read_b64_tr_b16 %5, %21\n\tds_read_b64_tr_b16 %6, %22\n\tds_read_b64_tr_b16 %7, %23\n\t"
                 "ds_read_b64_tr_b16 %8, %24\n\tds_read_b64_tr_b16 %9, %25\n\tds_read_b64_tr_b16 %10, %26\n\tds_read_b64_tr_b16 %11, %27\n\t"
                 "ds_read_b64_tr_b16 %12, %28\n\tds_read_b64_tr_b16 %13, %29\n\tds_read_b64_tr_b16 %14, %30\n\tds_read_b64_tr_b16 %15, %31\n\ts_waitcnt lgkmcnt(0)"
                 : "=&v"(r[0]), "=&v"(r[1]), "=&v"(r[2]), "=&v"(r[3]), "=&v"(r[4]), "=&v"(r[5]), "=&v"(r[6]), "=&v"(r[7]),
                   "=&v"(r[8]), "=&v"(r[9]), "=&v"(r[10]), "=&v"(r[11]), "=&v"(r[12]), "=&v"(r[13]), "=&v"(r[14]), "=&v"(r[15])
                 : "v"(a[0]), "v"(a[1]), "v"(a[2]), "v"(a[3]), "v"(a[4]), "v"(a[5]), "v"(a[6]), "v"(a[7]),
                   "v"(a[8]), "v"(a[9]), "v"(a[10]), "v"(a[11]), "v"(a[12]), "v"(a[13]), "v"(a[14]), "v"(a[15]) : "memory");
#pragma unroll
    for (int c = 0; c < 8; ++c) { u32x4 w; w.x = r[2 * c].x; w.y = r[2 * c].y; w.z = r[2 * c + 1].x; w.w = r[2 * c + 1].y; f[c] = __builtin_bit_cast(bf16x8, w); }
}
__device__ __forceinline__ bf16x8 row_frag(LAS unsigned char* tile, unsigned lane, unsigned rb, unsigned s) { return *(const LAS bf16x8*)(tile + row_addr16(lane, rb, s)); }

__device__ __forceinline__ void stage_ztile(const bf16_t* z, int b, int n, int cb, LAS unsigned char* tile, int tid) {
#pragma unroll
    for (int pass = 0; pass < 4; ++pass) { const int idx = tid + 512 * pass, row = idx >> 4, ch = idx & 15, p = n * 128 + row - 112;
        u32x4 v = *(const u32x4*)(z + (size_t)zrow_of(b, p < 0 ? 0 : p) * NIN + cb + ch * 8);
        if (p < 0) v = (u32x4){0u, 0u, 0u, 0u};
        *(LAS u32x4*)(tile + offb(row, ch)) = v; }
}
template <bool META> __device__ __forceinline__ void phase_ret(const Params& P, LAS unsigned char* lds);
template <bool LOWREG>
__device__ __forceinline__ void kv_compute(unsigned lbase_k, unsigned lbase_v, bf16_t* dst, int h, int lane, int wave) {
    const float g127 = exp2f(127.0f * log2_gamma(h));
    if constexpr (!LOWREG) {
        f32x4 acc[8];
#pragma unroll
        for (int i = 0; i < 8; ++i) acc[i] = (f32x4){0.f, 0.f, 0.f, 0.f};
#pragma unroll 1
        for (int ks = 0; ks < 4; ++ks) { const bf16x8 a = tr_frag(lbase_k, lane, wave, ks); bf16x8 vf[8]; tr_frag8(lbase_v, lane, ks, vf);
#pragma unroll
            for (int eb = 0; eb < 8; ++eb) acc[eb] = __builtin_amdgcn_mfma_f32_16x16x32_bf16(a, vf[eb], acc[eb], 0, 0, 0); }
#pragma unroll
        for (int eb = 0; eb < 8; ++eb) { u32x2 w; w.x = cvt_pk_bf16(acc[eb][0] * g127, acc[eb][1] * g127); w.y = cvt_pk_bf16(acc[eb][2] * g127, acc[eb][3] * g127);
            *(u32x2*)(dst + (size_t)(16 * eb + (lane & 15)) * 128 + 16 * wave + 4 * (lane >> 4)) = w; }
    } else {
#pragma unroll 1
        for (int eb = 0; eb < 8; ++eb) { f32x4 acc = (f32x4){0.f, 0.f, 0.f, 0.f};
#pragma unroll 1
            for (int ks = 0; ks < 4; ++ks) acc = __builtin_amdgcn_mfma_f32_16x16x32_bf16(tr_frag(lbase_k, lane, wave, ks), tr_frag(lbase_v, lane, eb, ks), acc, 0, 0, 0);
            u32x2 w; w.x = cvt_pk_bf16(acc[0] * g127, acc[1] * g127); w.y = cvt_pk_bf16(acc[2] * g127, acc[3] * g127);
            *(u32x2*)(dst + (size_t)(16 * eb + (lane & 15)) * 128 + 16 * wave + 4 * (lane >> 4)) = w; }
    }
}
__device__ __forceinline__ void phase_kv(const Params& P, LAS unsigned char* lds) {
    int tid_ = threadIdx.x; asm volatile("" : "+v"(tid_));
    const int tid = tid_, lane = tid & 63, wave = __builtin_amdgcn_readfirstlane(tid >> 6);
    const bf16_t* z = (const bf16_t*)(P.ws + WS_Z); bf16_t* G = (bf16_t*)(P.ws + WS_G);
    const unsigned lbase = (unsigned)(uintptr_t)lds;
    for (int it = blockIdx.x; it < 224; it += gridDim.x) {
        const int grp = it % 7, h = (it / 7) & 3, b = it / 28;
        const float lg = log2_gamma(h), cd = exp2f(128.0f * lg), g127 = exp2f(127.0f * lg);
        f32x4 acc[8];
#pragma unroll
        for (int i = 0; i < 8; ++i) acc[i] = (f32x4){0.f, 0.f, 0.f, 0.f};
#pragma unroll 1
        for (int j = 0; j < 4; ++j) { const int n = 4 * grp + 1 + j;
            stage_ztile(z, b, n, 512 + h * 128, lds, tid);
            stage_ztile(z, b, n, 1024 + h * 128, lds + 32768, tid);
            __syncthreads();
#pragma unroll
            for (int i = 0; i < 8; ++i) acc[i] = acc[i] * cd;
#pragma unroll 1
            for (int ks = 0; ks < 4; ++ks) { const bf16x8 a = tr_frag(lbase, lane, wave, ks); bf16x8 vf[8]; tr_frag8(lbase + 32768, lane, ks, vf);
#pragma unroll
                for (int eb = 0; eb < 8; ++eb) acc[eb] = __builtin_amdgcn_mfma_f32_16x16x32_bf16(a, vf[eb], acc[eb], 0, 0, 0); }
            __syncthreads(); }
        bf16_t* dst = G + ((size_t)((b * 4 + h) * 8 + grp)) * 16384;
#pragma unroll
        for (int eb = 0; eb < 8; ++eb) { u32x2 w; w.x = cvt_pk_bf16(acc[eb][0] * g127, acc[eb][1] * g127); w.y = cvt_pk_bf16(acc[eb][2] * g127, acc[eb][3] * g127);
            *(u32x2*)(dst + (size_t)(16 * eb + (lane & 15)) * 128 + 16 * wave + 4 * (lane >> 4)) = w; }
    }
    phase_ret<true>(P, lds);
}
template <int W> __device__ __forceinline__ void pool_part(bf16_t* z, int b, int n, int h, int tid) {
    const int j = tid & 127, qd = tid >> 7, colu = 2048 + h * 128 + j;
    constexpr int SB = 8;
#pragma unroll 1
    for (int sb = 0; sb < 32 / SB; ++sb) {
        const int p0 = n * 128 - 112 + 32 * qd + SB * sb;
        float u[SB + W - 1];
#pragma unroll
        for (int i = 0; i < SB + W - 1; ++i) { const int p = p0 - (W - 1) + i; const float v = bf2f(z[(size_t)zrow_of(b, p < 0 ? 0 : p) * NIN + colu]); u[i] = p >= 0 ? v : 0.f; }
        float sum = 0.f;
#pragma unroll
        for (int i = 0; i < W - 1; ++i) sum += u[i];
        float o[SB];
#pragma unroll
        for (int t = 0; t < SB; ++t) { const int p = p0 + t; const float ut = u[t + W - 1]; sum += ut;
            const float mean = (p + 1 < W) ? sum / (float)(p + 1 > 0 ? p + 1 : 1) : sum * (1.0f / (float)W);
            o[t] = mean - ut; sum -= u[t]; }
#pragma unroll
        for (int t = 0; t < SB; ++t) { const int p = p0 + t; if (p >= 0) z[(size_t)zrow_of(b, p) * NIN + 512 + h * 128 + j] = (bf16_t)(cvt_pk_bf16(o[t], 0.f) & 0xffffu); }
    }
}
template <bool META> __device__ __forceinline__ void phase_ret(const Params& P, LAS unsigned char* lds) {
    int tid_ = threadIdx.x; asm volatile("" : "+v"(tid_));
    const int tid = tid_, lane = tid & 63, wave = __builtin_amdgcn_readfirstlane(tid >> 6), g = lane >> 4, l15 = lane & 15;
    bf16_t* z = (bf16_t*)(P.ws + WS_Z); const bf16_t* G = (const bf16_t*)(P.ws + WS_G);
    const unsigned lbase = (unsigned)(uintptr_t)lds;
    LAS unsigned char* tq = lds; LAS unsigned char* tk = lds + 32768; LAS unsigned char* tst = lds + 98304;
    const int it_first = META ? (int)blockIdx.x - ((int)gridDim.x - 4) + 1024 : (int)blockIdx.x, it_end = META ? ((int)blockIdx.x >= (int)gridDim.x - 4 ? it_first + 1 : 0) : 256;
    for (int it = it_first; it < it_end; it += gridDim.x) {
        int grp, h, b; if (!META) { grp = it & 7; h = (it >> 3) & 3; b = it >> 5; } else { grp = 0; b = 0; h = it - 1024; asm volatile("" : "+s"(grp), "+s"(b)); }
        const float lg = log2_gamma(h), cd = exp2f(128.0f * lg);
        {
          const float gam = exp2f(lg); const bf16_t* kv0 = (const bf16_t*)(P.ws + WS_KV0) + (size_t)h * 16384; const bf16_t* gb = G + ((size_t)((b * 4 + h) * 8)) * 16384;
#pragma unroll 1
          for (int pass = 0; pass < 4; ++pass) { const int idx = tid + 512 * pass, row = idx >> 4, ch = idx & 15;
              float a[8];
#pragma unroll
              for (int i = 0; i < 8; ++i) a[i] = 0.f;
              if (!META) {
                  { const u32x4 v = *(const u32x4*)(kv0 + row * 128 + ch * 8); const float w = gam * exp2f(512.0f * lg * (float)grp);
#pragma unroll
                    for (int i = 0; i < 4; ++i) { a[2 * i] += w * bflo(v[i]); a[2 * i + 1] += w * bfhi(v[i]); } }
                  for (int gp = 0; gp < grp; ++gp) { const u32x4 v = *(const u32x4*)(gb + (size_t)gp * 16384 + row * 128 + ch * 8); const float w = gam * exp2f(512.0f * lg * (float)(grp - 1 - gp));
#pragma unroll
                    for (int i = 0; i < 4; ++i) { a[2 * i] += w * bflo(v[i]); a[2 * i + 1] += w * bfhi(v[i]); } } }
              u32x4 o; o.x = cvt_pk_bf16(a[0], a[1]); o.y = cvt_pk_bf16(a[2], a[3]); o.z = cvt_pk_bf16(a[4], a[5]); o.w = cvt_pk_bf16(a[6], a[7]);
              *(LAS u32x4*)(tst + offb(row, ch)) = o; } }
#pragma unroll 1
        for (int j = 0; j < (META ? 1 : 4); ++j) {
        const int n = META ? 0 : 4 * grp + 1 + j;
        stage_ztile(z, b, n, h * 128, tq, tid);
        stage_ztile(z, b, n, 512 + h * 128, tk, tid);
        stage_ztile(z, b, n, 1024 + h * 128, lds + 65536, tid);
        __syncthreads();
        f32x4 acc2[8];
#pragma unroll
        for (int i = 0; i < 8; ++i) acc2[i] = (f32x4){0.f, 0.f, 0.f, 0.f};
        const bool upd = !META && (j < 3);
        if (upd) {
#pragma unroll 1
            for (int ks = 0; ks < 4; ++ks) { const bf16x8 a = tr_frag(lbase + 32768, lane, wave, ks); bf16x8 vf[8]; tr_frag8(lbase + 65536, lane, ks, vf);
#pragma unroll
                for (int eb = 0; eb < 8; ++eb) acc2[eb] = __builtin_amdgcn_mfma_f32_16x16x32_bf16(a, vf[eb], acc2[eb], 0, 0, 0); } }
        if constexpr (META) kv_compute<true>(lbase + 32768, lbase + 65536, (bf16_t*)(P.ws + WS_KV0) + (size_t)h * 16384, h, lane, wave);
        switch (h) { case 0: pool_part<2>(z, b, n, h, tid); break; case 1: pool_part<4>(z, b, n, h, tid); break; case 2: pool_part<8>(z, b, n, h, tid); break; default: pool_part<16>(z, b, n, h, tid); break; }
        f32x4 acc[8];
#pragma unroll
        for (int i = 0; i < 8; ++i) acc[i] = (f32x4){0.f, 0.f, 0.f, 0.f};
        {
        bf16x8 qc[4];
#pragma unroll
        for (int ks = 0; ks < 4; ++ks) qc[ks] = row_frag(tq, lane, wave, ks);
#pragma unroll
        for (int ks = 0; ks < 4; ++ks) {
#pragma unroll
            for (int eb = 0; eb < 8; ++eb) acc[eb] = __builtin_amdgcn_mfma_f32_16x16x32_bf16(qc[ks], row_frag(tst, lane, eb, ks), acc[eb], 0, 0, 0);
            __builtin_amdgcn_sched_barrier(0); }
        }
        if (upd) {
            __syncthreads();
#pragma unroll
            for (int eb = 0; eb < 8; ++eb) { LAS u32x2* tp = (LAS u32x2*)(tst + offb(16 * eb + l15, 2 * wave + (g >> 1)) + 8 * (g & 1)); const u32x2 o = *tp; u32x2 w;
                w.x = cvt_pk_bf16(cd * (bflo(o.x) + acc2[eb][0]), cd * (bfhi(o.x) + acc2[eb][1])); w.y = cvt_pk_bf16(cd * (bflo(o.y) + acc2[eb][2]), cd * (bfhi(o.y) + acc2[eb][3])); *tp = w; }
        }
        bf16x8 qf[4];
#pragma unroll
        for (int ks = 0; ks < 4; ++ks) qf[ks] = row_frag(tq, lane, wave, ks);
        u32x2 pk[8];
#pragma unroll
        for (int mb = 0; mb < 8; ++mb) { f32x4 s = (f32x4){0.f, 0.f, 0.f, 0.f};
            if (mb <= wave) {
#pragma unroll
            for (int ks = 0; ks < 4; ++ks) s = __builtin_amdgcn_mfma_f32_16x16x32_bf16(row_frag(tk, lane, mb, ks), qf[ks], s, 0, 0, 0); }
            const int c = 16 * wave + l15, m0 = 16 * mb + 4 * g;
#pragma unroll
            for (int r = 0; r < 4; ++r) if (m0 + r > c) s[r] = 0.f;
            pk[mb].x = cvt_pk_bf16(s[0], s[1]); pk[mb].y = cvt_pk_bf16(s[2], s[3]); __builtin_amdgcn_sched_barrier(0); }
        __syncthreads();
#pragma unroll
        for (int mb = 0; mb < 8; ++mb) *(LAS u32x2*)(tk + offb(16 * wave + l15, 2 * mb + (g >> 1)) + 8 * (g & 1)) = pk[mb];
#pragma unroll 1
        for (int ks = 0; ks < 4; ++ks) { if (2 * ks <= wave) {
            const bf16x8 pf = row_frag(tk, lane, wave, ks); bf16x8 vf[8]; tr_frag8(lbase + 65536, lane, ks, vf);
#pragma unroll
            for (int eb = 0; eb < 8; ++eb) acc[eb] = __builtin_amdgcn_mfma_f32_16x16x32_bf16(pf, vf[eb], acc[eb], 0, 0, 0); } }
#pragma unroll
        for (int r = 0; r < 4; ++r) { float s = 0.f;
#pragma unroll
            for (int eb = 0; eb < 8; ++eb) s += acc[eb][r];
            s += __shfl_xor(s, 1); s += __shfl_xor(s, 2); s += __shfl_xor(s, 4); s += __shfl_xor(s, 8);
            const float mu = s * (1.0f / 128.0f); float q = 0.f;
#pragma unroll
            for (int eb = 0; eb < 8; ++eb) { const float d = acc[eb][r] - mu; q += d * d; }
            q += __shfl_xor(q, 1); q += __shfl_xor(q, 2); q += __shfl_xor(q, 4); q += __shfl_xor(q, 8);
            const float rstd = rsqrtf(q * (1.0f / 128.0f) + 1e-6f);
            const int c = 16 * wave + 4 * g + r;
#pragma unroll
            for (int eb = 0; eb < 8; ++eb) { const int e = 16 * eb + l15;
                *(LAS bf16_t*)(tq + offb(c, e >> 3) + (e & 7) * 2) = (bf16_t)(cvt_pk_bf16((acc[eb][r] - mu) * rstd, 0.f) & 0xffffu); } }
#pragma unroll
        for (int i = 0; i < 4; ++i) { const int idx = lane + 64 * i, c = 16 * wave + (idx >> 4), ch = idx & 15, p = n * 128 + c - 112;
            if (p >= 0) { const size_t zr = (size_t)zrow_of(b, p) * NIN;
                const u32x4 y = *(const LAS u32x4*)(tq + offb(c, ch)); const u32x4 gg = *(const u32x4*)(z + zr + 1536 + h * 128 + ch * 8);
                u32x4 o;
#pragma unroll
                for (int k = 0; k < 4; ++k) o[k] = cvt_pk_bf16(bflo(y[k]) * silu_f(bflo(gg[k])), bfhi(y[k]) * silu_f(bfhi(gg[k])));
                *(u32x4*)(z + zr + h * 128 + ch * 8) = o; } }
        __syncthreads();
        }
    }
}
__device__ __forceinline__ void phase_final(const Params& P) {
    int tid_ = threadIdx.x; asm volatile("" : "+v"(tid_));
    const int tid = tid_, lane = tid & 63, wave = tid >> 6; const int gw = blockIdx.x * 8 + wave, NGW = gridDim.x * 8;
    const u64* rowsq = (const u64*)(P.ws + WS_ROWSQ) + (size_t)6 * TM; const f32x4* gn = (const f32x4*)P.in[17];
    f32x4 gv[4];
#pragma unroll
    for (int j = 0; j < 4; ++j) gv[j] = gn[lane + 64 * j];
    for (int m = gw; m < TS; m += NGW) { const float rs = rsqrtf(rq2f(rowsq[m]) * (1.0f / DM) + 1e-6f); f32x4* o = (f32x4*)(P.out + (size_t)m * DM);
#pragma unroll
        for (int j = 0; j < 4; ++j) o[lane + 64 * j] = o[lane + 64 * j] * rs * gv[j]; }
}

__global__ void __launch_bounds__(512, 2) mk_fwd(Params P) {
    extern __shared__ __attribute__((aligned(16))) unsigned char lds_raw[];
    LAS unsigned char* lds = (LAS unsigned char*)lds_raw;
    cg::grid_group grid = cg::this_grid();
    const int lo = P.ph_lo, hi = P.ph_hi;
    unsigned char* ws = P.ws;
    u64* rowsq = (u64*)(ws + WS_ROWSQ); float* hmeta = (float*)(ws + WS_HMETA); bf16_t* hb = (bf16_t*)(ws + WS_HB); bf16_t* z = (bf16_t*)(ws + WS_Z);
    const float* tab = (const float*)(ws + WS_TAB);
#define IN(k) (lo <= (k) && (k) < hi)
    { LAS unsigned* stw = (LAS unsigned*)(lds + 131072); if (threadIdx.x < 4) stw[threadIdx.x] = 0u; }
    __syncthreads();
    const XcdBarrier xbar = xcd_barrier_post((unsigned*)(ws + WS_BAR), (volatile LAS unsigned*)(lds + 131072));
    if (lo < 0) grid.sync();
#define SEAM(k) do { if ((k) + 1 < hi) xcd_barrier(xbar); } while (0)
    if (IN(0)) { if (PHMASK & 1) phase_prep(P, lds); SEAM(0); }
    for (int l = 0; l < 2; ++l) {
        const int pb = 1 + 10 * l; unsigned char* wl = ws + WS_W + l * W_LAYER;
        pg8::StaticOrder S;
        if (IN(pb + 0)) { pg8::Gemm g{hb, (const bf16_t*)(wl + W_W1), TS, 2 * FF, DM, DM}; S.init(TS, 2 * FF, gridDim.x, blockIdx.x);
            if (PHMASK & 256) skinny<0>(lds, SkArgs{hb + (size_t)TS * DM, DM, (const bf16_t*)(wl + W_W1), DM, rowsq + (size_t)(3 * l) * TM, nullptr, hmeta, hb, z, tab, 0.f});
            EpiUp E{rowsq + (size_t)(3 * l) * TM, z}; if (PHMASK & 2) pg8::gemm_phase(lds, g, S, E); SEAM(pb + 0); }
        if (IN(pb + 1)) { pg8::Gemm g{z, (const bf16_t*)(wl + W_W1D), TS, DM, FF, FF}; S.init(TS, DM, gridDim.x, blockIdx.x);
            if (PHMASK & 256) skinny<1>(lds, SkArgs{z + (size_t)TS * FF, FF, (const bf16_t*)(wl + W_W1D), FF, nullptr, rowsq + (size_t)(3 * l + 1) * TM, hmeta, hb, z, tab, 0.5f});
            EpiDown<false, false> E{l == 0 ? P.in[0] : P.out, nullptr, hb, rowsq + (size_t)(3 * l + 1) * TM, 0.5f}; if (PHMASK & 4) pg8::gemm_phase(lds, g, S, E); SEAM(pb + 1); }
        if (IN(pb + 2)) { pg8::Gemm g{hb, (const bf16_t*)(wl + W_WIN), TS, NIN, DM, DM}; S.init(TS, NIN, gridDim.x, blockIdx.x);
            if (PHMASK & 256) skinny<2>(lds, SkArgs{hb + (size_t)TS * DM, DM, (const bf16_t*)(wl + W_WIN), DM, rowsq + (size_t)(3 * l + 1) * TM, nullptr, hmeta, hb, z, tab, 0.f});
            EpiIn E{rowsq + (size_t)(3 * l + 1) * TM, z, tab}; if (PHMASK & 8) pg8::gemm_phase(lds, g, S, E); SEAM(pb + 2); }
        if (IN(pb + 3)) { if (PHMASK & 16) phase_kv(P, lds); SEAM(pb + 3); }
        if (IN(pb + 5)) { if (PHMASK & 64) phase_ret<false>(P, lds); SEAM(pb + 5); }
        if (IN(pb + 6)) { pg8::Gemm g{z, (const bf16_t*)(wl + W_WRP), TS, DM, DM, NIN}; S.init(TS, DM, gridDim.x, blockIdx.x);
            if (PHMASK & 256) skinny<3>(lds, SkArgs{z + (size_t)TS * NIN, NIN, (const bf16_t*)(wl + W_WRP), DM, nullptr, nullptr, hmeta, hb, z, tab, 0.f});
            EpiMix E{z}; if (PHMASK & 128) pg8::gemm_phase(lds, g, S, E); SEAM(pb + 6); }
        if (IN(pb + 7)) { pg8::Gemm g{z + 1024, (const bf16_t*)(wl + W_WO), TS, DM, DM, NIN}; S.init(TS, DM, gridDim.x, blockIdx.x);
            if (PHMASK & 256) skinny<1>(lds, SkArgs{z + (size_t)TS * NIN + 1024, NIN, (const bf16_t*)(wl + W_WO), DM, nullptr, rowsq + (size_t)(3 * l + 2) * TM, hmeta, hb, z, tab, 1.0f});
            EpiDown<true, false> E{nullptr, nullptr, hb, rowsq + (size_t)(3 * l + 2) * TM, 1.0f}; pg8::gemm_phase(lds, g, S, E); SEAM(pb + 7); }
        if (IN(pb + 8)) { pg8::Gemm g{hb, (const bf16_t*)(wl + W_W2), TS, 2 * FF, DM, DM}; S.init(TS, 2 * FF, gridDim.x, blockIdx.x);
            if (PHMASK & 256) skinny<0>(lds, SkArgs{hb + (size_t)TS * DM, DM, (const bf16_t*)(wl + W_W2), DM, rowsq + (size_t)(3 * l + 2) * TM, nullptr, hmeta, hb, z, tab, 0.f});
            EpiUp E{rowsq + (size_t)(3 * l + 2) * TM, z}; pg8::gemm_phase(lds, g, S, E); SEAM(pb + 8); }
        if (IN(pb + 9)) { pg8::Gemm g{z, (const bf16_t*)(wl + W_W2D), TS, DM, FF, FF}; S.init(TS, DM, gridDim.x, blockIdx.x);
            if (PHMASK & 256) skinny<1>(lds, SkArgs{z + (size_t)TS * FF, FF, (const bf16_t*)(wl + W_W2D), FF, nullptr, rowsq + (size_t)(3 * l + 3) * TM, hmeta, hb, z, tab, 0.5f});
            const bool fuse_final = (l == 1) && (gridDim.x == 256);
            if (fuse_final) { EpiFinal E{P.out, hb, rowsq + (size_t)6 * TM, (unsigned*)(ws + WS_CNT), P.in[17]}; pg8::gemm_phase(lds, g, S, E); }
            else { EpiDown<true, true> E{nullptr, P.out, hb, rowsq + (size_t)(3 * l + 3) * TM, 0.5f}; pg8::gemm_phase(lds, g, S, E); }
            if (l == 1 && !fuse_final) { xcd_barrier(xbar); phase_final(P); }
            SEAM(pb + 9); }
    }
#undef IN
#undef SEAM
}

extern "C" void kernel_launch(void* const* d_in, const int* in_sizes, int n_in, void* d_out, int out_size, void* d_ws, size_t ws_size, hipStream_t stream) {
    static int grid = 0;
    if (grid == 0) {
        if (n_in != 18 || in_sizes[0] != TS * DM || out_size != TS * DM || ws_size < WS_END) { fprintf(stderr, "kernel_launch: unexpected shapes (n_in %d, in0 %d, out %d, ws %zu < %zu)\n", n_in, n_in > 0 ? in_sizes[0] : -1, out_size, ws_size, (size_t)WS_END); grid = -1; return; }
        int dev = 0, cus = 0, per_cu = 0;
        hipGetDevice(&dev); hipDeviceGetAttribute(&cus, hipDeviceAttributeMultiprocessorCount, dev);
        if (hipFuncSetAttribute((const void*)mk_fwd, hipFuncAttributeMaxDynamicSharedMemorySize, LDS_BYTES) != hipSuccess) { fprintf(stderr, "kernel_launch: hipFuncSetAttribute failed\n"); grid = -1; return; }
        if (hipOccupancyMaxActiveBlocksPerMultiprocessor(&per_cu, (const void*)mk_fwd, 512, LDS_BYTES) != hipSuccess || per_cu < 1) { fprintf(stderr, "kernel_launch: occupancy query says %d blocks/CU\n", per_cu); per_cu = 1; }
        (void)hipGetLastError();
        grid = cus * per_cu;
    }
    if (grid < 0) return;
    Params p{};
    for (int i = 0; i < 18; ++i) p.in[i] = (const float*)d_in[i];
    p.out = (float*)d_out; p.ws = (unsigned char*)d_ws;
#if MK_MULTI
    for (int ph = 0; ph < NPH; ++ph) { p.ph_lo = ph; p.ph_hi = ph + 1; hipLaunchKernelGGL(mk_fwd, dim3(grid), dim3(512), LDS_BYTES, stream, p); }
#else
    p.ph_lo = 0; p.ph_hi = NPH;
    (void)hipMemsetAsync((unsigned char*)d_ws + WS_BAR, 0, XCD_BAR_WORDS * 4, stream);
    void* args[] = {&p};
    hipError_t e = hipLaunchCooperativeKernel((const void*)mk_fwd, dim3(grid), dim3(512), args, LDS_BYTES, stream);
    if (e != hipSuccess) fprintf(stderr, "cooperative launch failed: %s (grid %d)\n", hipGetErrorString(e), grid);
#endif
}
```

```cpp
#include <hip/hip_runtime.h>
#include <hip/hip_cooperative_groups.h>
#include <cstdio>
#include <cstdint>
namespace cg = cooperative_groups;

#ifndef PHMASK
#define PHMASK 0xffff
#endif
#ifndef MK_MULTI
#define MK_MULTI 0
#endif

#define LAS __attribute__((address_space(3)))
typedef unsigned short bf16_t;
typedef short bf16x8 __attribute__((ext_vector_type(8)));
typedef float f32x4 __attribute__((ext_vector_type(4)));
typedef unsigned u32x4 __attribute__((ext_vector_type(4)));
typedef unsigned u32x2 __attribute__((ext_vector_type(2)));
typedef unsigned long long u64;
__device__ __forceinline__ u64 f2rq(float s) { return (u64)(s * 4096.0f + 0.5f); }
__device__ __forceinline__ float rq2f(u64 q) { return (float)(unsigned)q * (1.0f / 4096.0f); }
__device__ __forceinline__ unsigned rq_lo(const u64* p, int idx) { return ((const unsigned*)p)[2 * idx]; }
__device__ __forceinline__ float rqlo2f(unsigned lo) { return (float)lo * (1.0f / 4096.0f); }

constexpr int DM = 1024, NBATCH = 8, SEQ = 4096, NMETA = 16, FF = 2816, NIN = 4608;
constexpr int TS = NBATCH * SEQ;
constexpr int TM = 33024;
constexpr int NPOS = SEQ + NMETA;
constexpr int NCH = 33;
constexpr int NPH = 21;
constexpr int LDS_BYTES = 131072 + 16;

constexpr size_t WS_ROWSQ = 0;
constexpr size_t WS_BAR   = 1900544;
constexpr size_t WS_CNT   = WS_BAR + 16384;
constexpr size_t WS_TAB   = 2u << 20;
constexpr size_t WS_HMETA = WS_TAB + (size_t)NPOS * 64 * 8 + 65536 - ((size_t)NPOS * 64 * 8) % 65536;
constexpr size_t WS_KV0   = WS_HMETA + 256 * 1024 * 4;
constexpr size_t WS_W     = WS_KV0 + 4 * 16384 * 4;
constexpr size_t W_W1 = 0, W_W1D = W_W1 + (size_t)2 * FF * DM * 2, W_WIN = W_W1D + (size_t)DM * FF * 2, W_WRP = W_WIN + (size_t)NIN * DM * 2,
                 W_WO = W_WRP + (size_t)DM * DM * 2, W_W2 = W_WO + (size_t)DM * DM * 2, W_W2D = W_W2 + (size_t)2 * FF * DM * 2, W_LAYER = W_W2D + (size_t)DM * FF * 2;
constexpr size_t WS_HB    = WS_W + 2 * W_LAYER;
constexpr size_t HB_BYTES = (size_t)NBATCH * 4 * NCH * 16384 * 4;
constexpr size_t WS_Z     = WS_HB + HB_BYTES;
constexpr size_t WS_G     = WS_Z + (size_t)TM * NIN * 2;
constexpr size_t WS_END   = WS_G + (size_t)NBATCH * 4 * 8 * 16384 * 2;

struct Params { const float* in[18]; float* out; unsigned char* ws; int ph_lo, ph_hi; };

__device__ __forceinline__ unsigned cvt_pk_bf16(float lo, float hi) { unsigned r; asm("v_cvt_pk_bf16_f32 %0, %1, %2" : "=v"(r) : "v"(lo), "v"(hi)); return r; }
__device__ __forceinline__ float bflo(unsigned w) { return __uint_as_float(w << 16); }
__device__ __forceinline__ float bfhi(unsigned w) { return __uint_as_float(w & 0xffff0000u); }
__device__ __forceinline__ float bf2f(bf16_t b) { return __uint_as_float(((unsigned)b) << 16); }
__device__ __forceinline__ float fast_rcp(float x) { return __builtin_amdgcn_rcpf(x); }
__device__ __forceinline__ float expneg(float x) { return __expf(-x); }
__device__ __forceinline__ float silu_f(float x) { return x * fast_rcp(1.0f + expneg(x)); }
__device__ __forceinline__ float wave_sum(float v) {
#pragma unroll
    for (int o = 1; o < 64; o <<= 1) v += __shfl_xor(v, o);
    return v;
}
__device__ __forceinline__ int zrow_of(int b, int p) { return p < NMETA ? TS + p : b * SEQ + (p - NMETA); }
__device__ __forceinline__ float log2_gamma(int head) { return log2f(1.0f - exp2f(-5.0f - (float)head)); }


#define XB_TMO      128
#define XB_XCNT(j)  (256  + 64 * (j))
#define XB_XSUB(j)  (1280 + 64 * (j))
#define XB_XGEN(j)  (2304 + 64 * (j))
#define XB_TOP      3328
#define XB_TOPGEN   3392
#define XCD_BAR_WORDS 3456
#define XB_SPIN_CAP (1u << 18)
__device__ __forceinline__ unsigned xb_ld(unsigned* p)              { return __hip_atomic_load(p, __ATOMIC_RELAXED, __HIP_MEMORY_SCOPE_AGENT); }
__device__ __forceinline__ unsigned xb_add(unsigned* p, unsigned v) { return __hip_atomic_fetch_add(p, v, __ATOMIC_RELAXED, __HIP_MEMORY_SCOPE_AGENT); }
__device__ __forceinline__ unsigned xb_xcc_id() { return (unsigned)__builtin_amdgcn_s_getreg((3 << 11) | 20) & 0xFu; }
#define XB_SPIN(cond, bar) do { unsigned _sp = 0; while (cond) { __builtin_amdgcn_s_sleep(1); \
    if ((++_sp & 255u) == 0u) { if (xb_ld(&(bar)[XB_TMO])) break; if (_sp > XB_SPIN_CAP) { atomicAdd(&(bar)[XB_TMO], 1u); break; } } } } while (0)
struct XcdBarrier { unsigned* bar; unsigned x; volatile LAS unsigned* st; };
__device__ __forceinline__ XcdBarrier xcd_barrier_post(unsigned* bar, volatile LAS unsigned* st) {
    XcdBarrier b; b.bar = bar; b.x = xb_xcc_id(); b.st = st;
    if (threadIdx.x == 0) (void)xb_add(&bar[XB_XCNT(b.x)], 1u);
    return b;
}
__device__ __forceinline__ void xcd_barrier_complete(unsigned* bar, unsigned x, unsigned& nloc, unsigned& nx) {
    const unsigned G = gridDim.x * gridDim.y * gridDim.z;
    unsigned sum, cnt, mine, sp = 0u;
    for (;;) {
        sum = 0u; cnt = 0u; mine = 0u;
#pragma unroll
        for (unsigned j = 0; j < 16; ++j) { const unsigned c = xb_ld(&bar[XB_XCNT(j)]); sum += c; cnt += (c > 0u) ? 1u : 0u; mine = (j == x) ? c : mine; }
        if (sum == G) break;
        __builtin_amdgcn_s_sleep(1);
        if ((++sp & 255u) == 0u) { if (xb_ld(&bar[XB_TMO])) break; if (sp > XB_SPIN_CAP) { atomicAdd(&bar[XB_TMO], 1u); break; } }
    }
    nloc = mine > 0u ? mine : 1u; nx = cnt > 0u ? cnt : 1u;
}
__device__ __forceinline__ void xcd_barrier(const XcdBarrier& b) {
    asm volatile("s_waitcnt vmcnt(0)" ::: "memory");
    __syncthreads();
    if (threadIdx.x == 0) {
        unsigned* bar = b.bar;
        __builtin_amdgcn_s_waitcnt(0);
        unsigned nloc = b.st[0], nx = b.st[1];
        if (nloc == 0u) { xcd_barrier_complete(bar, b.x, nloc, nx); b.st[0] = nloc; b.st[1] = nx; }
        const unsigned old = xb_add(&bar[XB_XSUB(b.x)], 1u);
        const unsigned gen = old / nloc;
        if (old + 1u == (gen + 1u) * nloc) {
            __builtin_amdgcn_fence(__ATOMIC_RELEASE, "agent");
            asm volatile("s_waitcnt vmcnt(0)" ::: "memory");
            const unsigned og = xb_add(&bar[XB_TOP], 1u);
            const unsigned tg = og / nx;
            if (og + 1u == (tg + 1u) * nx) xb_add(&bar[XB_TOPGEN], 1u);
            else XB_SPIN(xb_ld(&bar[XB_TOPGEN]) == tg, bar);
            __builtin_amdgcn_fence(__ATOMIC_ACQUIRE, "agent");
            xb_add(&bar[XB_XGEN(b.x)], 1u);
            asm volatile("s_waitcnt vmcnt(0)" ::: "memory");
        } else {
            XB_SPIN(xb_ld(&bar[XB_XGEN(b.x)]) == gen, bar);
            __builtin_amdgcn_fence(__ATOMIC_ACQUIRE, "agent");
            asm volatile("s_waitcnt vmcnt(0)" ::: "memory");
        }
    }
    __syncthreads();
}

namespace pg8 {
constexpr int BM = 256, BK = 64, HALF = 128, HTB = HALF * BK * 2, STAGE_BYTES = 8 * HTB, NXCD = 8, WGM = 8;
__host__ __device__ __forceinline__ int lds_byte(int r, int c) { const int st = (r >> 4) * 2 + (c >> 5), rr = r & 15, cc = c & 31, ob = rr * 64 + cc * 2; return st * 1024 + (ob ^ (((ob >> 9) & 1) << 5)); }
__host__ __device__ __forceinline__ void stage_rc(int b, int& R, int& C) { const int st = b / 1024, sb = b % 1024, swz = sb ^ (((sb >> 9) & 1) << 5); R = (st >> 1) * 16 + swz / 64; C = (st & 1) * 32 + (swz % 64) / 2; }
__host__ __device__ __forceinline__ int perm32(int rho) { const int n = rho >> 4, i = rho & 15; return 8 * (i >> 2) + 4 * n + (i & 3); }
struct Unit { int pm, pn; };
struct Gemm { const bf16_t* A; const bf16_t* Bt; int M, N, K, lda; };
struct StaticOrder {
    int nM, nN, nwg, G, c;
    __device__ void init(int M, int N, int G_, int c_) { nM = M / BM; nN = N / BM; nwg = nM * nN; G = G_; c = c_; }
    __device__ bool next(int i, Unit& u) const {
        const long L = (long)i * G + c; if (L >= nwg) return false;
        int wgid = (int)L; { const int q = nwg / NXCD, r = nwg % NXCD, xcd = wgid % NXCD, off = wgid / NXCD; wgid = (xcd < r ? xcd * (q + 1) : r * (q + 1) + (xcd - r) * q) + off; }
        const int nig = WGM * nN, gid = wgid / nig, fm = gid * WGM, gsz = (nM - fm) < WGM ? (nM - fm) : WGM;
        u.pm = fm + ((wgid % nig) % gsz); u.pn = (wgid % nig) / gsz; return true;
    }
};
template <class Epi>
__device__ __forceinline__ void gemm_phase(LAS unsigned char* lds, const Gemm g, const StaticOrder& S, const Epi& E) {
    int tid_ = threadIdx.x; asm volatile("" : "+v"(tid_));
    const int tid = tid_, wid = __builtin_amdgcn_readfirstlane(tid >> 6), lane = tid & 63, wr = wid >> 2, wc = wid & 3, fr = lane & 15, fq = lane >> 4;
    const int K = g.K, nt = K / BK, lda = g.lda;
    unsigned voffA[2], voffB[2];
#pragma unroll
    for (int i = 0; i < 2; ++i) { int R, C; stage_rc(tid * 16 + i * 8192, R, C); const int Rb = (R & ~31) + perm32(R & 31);
        voffA[i] = (unsigned)(R * lda + C) * 2u; voffB[i] = (unsigned)(Rb * K + C) * 2u; }
    const size_t kstep = (size_t)(BK * 2);
    const size_t hsA = (size_t)HALF * lda * 2, hsB = (size_t)HALF * K * 2;
    const size_t tsA = 2 * hsA, tsB = 2 * hsB;
    const unsigned ldsw = (unsigned)wid * 1024u;
    const int aoff = lds_byte(wr * 64 + fr, fq * 8), boff = lds_byte(wc * 32 + fr, fq * 8);
#define PG8_SA(b, h) (((b) * 2 + (h)) * HTB)
#define PG8_SB(b, h) ((4 + (b) * 2 + (h)) * HTB)
#define PG8_STAGE(bufoff, gbase, voff) do { _Pragma("unroll") for (int _i = 0; _i < 2; ++_i) \
        __builtin_amdgcn_global_load_lds((const unsigned*)((const char*)(gbase) + (voff)[_i]), (LAS unsigned*)(lds + (bufoff) + ldsw + _i * 8192), 16, 0, 0); } while (0)
#define PG8_LDA(dst, b, h) do { _Pragma("unroll") for (int m = 0; m < 4; ++m) _Pragma("unroll") for (int k = 0; k < 2; ++k) dst[m][k] = *(const LAS bf16x8*)(lds + PG8_SA(b, h) + aoff + m * 2048 + k * 1024); } while (0)
#define PG8_LDB(dst, b, h) do { _Pragma("unroll") for (int n = 0; n < 2; ++n) _Pragma("unroll") for (int k = 0; k < 2; ++k) dst[n][k] = *(const LAS bf16x8*)(lds + PG8_SB(b, h) + boff + n * 2048 + k * 1024); } while (0)
#define PG8_MMA(ai, bj, At, Bt) do { __builtin_amdgcn_s_setprio(1); _Pragma("unroll") for (int m = 0; m < 4; ++m) _Pragma("unroll") for (int n = 0; n < 2; ++n) _Pragma("unroll") for (int k = 0; k < 2; ++k) \
        acc[ai][bj][m][n] = __builtin_amdgcn_mfma_f32_16x16x32_bf16(Bt[n][k], At[m][k], acc[ai][bj][m][n], 0, 0, 0); __builtin_amdgcn_s_setprio(0); } while (0)
#define PG8_WAIT_V(n) asm volatile("s_waitcnt vmcnt(" #n ")" ::: "memory")
#define PG8_WAIT_L(n) asm volatile("s_waitcnt lgkmcnt(" #n ")" ::: "memory")
#define PG8_BAR __builtin_amdgcn_s_barrier()
#define PG8_SCHED __builtin_amdgcn_sched_barrier(0)
    Unit cur, nxt; int ui = 0;
    if (!S.next(0, cur)) return;
    f32x4 acc[2][2][4][2];
#pragma unroll
    for (int a = 0; a < 2; ++a)
#pragma unroll
        for (int b = 0; b < 2; ++b)
#pragma unroll
            for (int m = 0; m < 4; ++m)
#pragma unroll
                for (int n = 0; n < 2; ++n) acc[a][b][m][n] = (f32x4){0.f, 0.f, 0.f, 0.f};
    bf16x8 At[4][2], B0[2][2], B1[2][2];
    float pre[8];
#pragma unroll
    for (int i = 0; i < 8; ++i) pre[i] = 0.f;
    const char* cA = (const char*)g.A + (size_t)cur.pm * tsA; const char* cB = (const char*)g.Bt + (size_t)cur.pn * tsB;
    PG8_STAGE(PG8_SB(0, 0), cB, voffB); PG8_STAGE(PG8_SB(0, 1), cB + hsB, voffB); PG8_STAGE(PG8_SA(0, 0), cA, voffA); PG8_STAGE(PG8_SA(0, 1), cA + hsA, voffA);
    if (wr == 1) PG8_BAR;
    PG8_WAIT_V(2); PG8_BAR;
    PG8_STAGE(PG8_SB(1, 0), cB + kstep, voffB); PG8_STAGE(PG8_SA(1, 0), cA + kstep, voffA); PG8_STAGE(PG8_SB(1, 1), cB + hsB + kstep, voffB);
    PG8_WAIT_V(6); PG8_BAR;
    for (;;) {
        const bool has_next = S.next(ui + 1, nxt);
        const char* nA = has_next ? (const char*)g.A + (size_t)nxt.pm * tsA : cA; const char* nB = has_next ? (const char*)g.Bt + (size_t)nxt.pn * tsB : cB;
        for (int t = 0; t < nt; t += 2) {
            const bool last = (t == nt - 2);
            const char* a1 = cA + (size_t)(t + 1) * kstep;
            const char* a2 = last ? nA : cA + (size_t)(t + 2) * kstep; const char* b2 = last ? nB : cB + (size_t)(t + 2) * kstep;
            const char* a3 = a2 + kstep; const char* b3 = b2 + kstep;
            if constexpr (Epi::MID) { if (t == 8) E.mid(acc, cur, wr, wc, fr, fq); }
            if constexpr (Epi::PRE) { if (last) E.prefetch(pre, cur, wr, fr); }
            PG8_LDB(B0, 0, 0); PG8_LDB(B1, 0, 1); PG8_SCHED; PG8_LDA(At, 0, 0); PG8_STAGE(PG8_SA(1, 1), a1 + hsA, voffA);
            PG8_WAIT_V(8); PG8_WAIT_L(0); PG8_BAR; PG8_MMA(0, 0, At, B0); PG8_MMA(0, 1, At, B1); PG8_BAR; PG8_SCHED;
            PG8_LDA(At, 0, 1); PG8_STAGE(PG8_SB(0, 0), b2, voffB); PG8_STAGE(PG8_SB(0, 1), b2 + hsB, voffB); PG8_STAGE(PG8_SA(0, 0), a2, voffA);
            PG8_WAIT_V(8); PG8_WAIT_L(0); PG8_BAR; PG8_MMA(1, 0, At, B0); PG8_MMA(1, 1, At, B1); PG8_BAR; PG8_SCHED;
            PG8_LDB(B0, 1, 0); PG8_LDB(B1, 1, 1); PG8_SCHED; PG8_LDA(At, 1, 0); PG8_STAGE(PG8_SA(0, 1), a2 + hsA, voffA);
            PG8_WAIT_V(8); PG8_WAIT_L(0); PG8_BAR; PG8_MMA(0, 0, At, B0); PG8_MMA(0, 1, At, B1); PG8_BAR; PG8_SCHED;
            PG8_LDA(At, 1, 1); PG8_STAGE(PG8_SB(1, 0), b3, voffB); PG8_STAGE(PG8_SB(1, 1), b3 + hsB, voffB); PG8_STAGE(PG8_SA(1, 0), a3, voffA);
            PG8_WAIT_V(8); PG8_WAIT_L(0); PG8_BAR; PG8_MMA(1, 0, At, B0); PG8_MMA(1, 1, At, B1); PG8_BAR; PG8_SCHED;
        }
        if (wr == 0) PG8_BAR;
        E(acc, cur, wr, wc, fr, fq, pre);
        if (!has_next) break;
#pragma unroll
        for (int a = 0; a < 2; ++a)
#pragma unroll
            for (int b = 0; b < 2; ++b)
#pragma unroll
                for (int m = 0; m < 4; ++m)
#pragma unroll
                    for (int n = 0; n < 2; ++n) acc[a][b][m][n] = (f32x4){0.f, 0.f, 0.f, 0.f};
        cur = nxt; cA = nA; cB = nB; ++ui;
        if (wr == 1) PG8_BAR;
    }
    PG8_WAIT_V(0);
    PG8_BAR;
#undef PG8_SA
#undef PG8_SB
#undef PG8_STAGE
#undef PG8_LDA
#undef PG8_LDB
#undef PG8_MMA
#undef PG8_WAIT_V
#undef PG8_WAIT_L
#undef PG8_BAR
#undef PG8_SCHED
}
}
using pg8::Unit;
typedef const f32x4 (&AccRef)[2][2][4][2];

__device__ __forceinline__ u32x4 pack8(const f32x4 a, const f32x4 b) { u32x4 w; w.x = cvt_pk_bf16(a[0], a[1]); w.y = cvt_pk_bf16(a[2], a[3]); w.z = cvt_pk_bf16(b[0], b[1]); w.w = cvt_pk_bf16(b[2], b[3]); return w; }

struct EpiUp {
    static constexpr bool MID = false, PRE = true;
    const u64* rowsq; bf16_t* act;
    __device__ __forceinline__ void prefetch(float (&pre)[8], const Unit& u, int wr, int fr) const {
        const int row0 = u.pm * 256 + wr * 64 + fr;
#pragma unroll
        for (int i = 0; i < 8; ++i) pre[i] = __uint_as_float(rq_lo(rowsq, row0 + (i >> 2) * 128 + (i & 3) * 16));
    }
    __device__ __forceinline__ void operator()(AccRef acc, const Unit& u, int wr, int wc, int fr, int fq, const float (&pre)[8]) const {
        int row0 = u.pm * 256 + wr * 64 + fr; asm volatile("" : "+v"(row0)); const int col0 = u.pn * 128 + wc * 32 + 8 * fq;
#pragma unroll
        for (int ai = 0; ai < 2; ++ai)
#pragma unroll
            for (int m = 0; m < 4; ++m) { const int r = row0 + ai * 128 + m * 16; const float rs = rsqrtf(rqlo2f(__float_as_uint(pre[ai * 4 + m])) * (1.0f / DM) + 1e-6f);
                const float k1 = -1.4426950408889634f * rs, rs2 = rs * rs;
                f32x4 o0, o1;
#pragma unroll
                for (int i = 0; i < 4; ++i) {
                    const float g0 = acc[ai][0][m][0][i], g1 = acc[ai][0][m][1][i];
                    o0[i] = (g0 * acc[ai][1][m][0][i]) * (rs2 * fast_rcp(1.0f + __builtin_amdgcn_exp2f(g0 * k1)));
                    o1[i] = (g1 * acc[ai][1][m][1][i]) * (rs2 * fast_rcp(1.0f + __builtin_amdgcn_exp2f(g1 * k1))); }
                *(u32x4*)(act + (size_t)r * FF + col0) = pack8(o0, o1); asm volatile("" ::: "memory"); }
    }
};
template <bool B16, bool W32>
struct EpiDown {
    static constexpr bool MID = false, PRE = false;
    const float* base; float* out; bf16_t* hb; u64* rowsq_out; float scale;
    __device__ __forceinline__ void operator()(AccRef acc, const Unit& u, int wr, int wc, int fr, int fq, const float (&pre)[8]) const {
        int row0 = u.pm * 256 + wr * 64 + fr; asm volatile("" : "+v"(row0)); const int col0 = u.pn * 256 + wc * 32 + 8 * fq;
#pragma unroll
        for (int ai = 0; ai < 2; ++ai)
#pragma unroll
            for (int mp = 0; mp < 2; ++mp) {
                f32x4 b[2][2][2];
#pragma unroll
                for (int q = 0; q < 2; ++q) { const int r = row0 + ai * 128 + (2 * mp + q) * 16;
#pragma unroll
                    for (int bj = 0; bj < 2; ++bj) { const int c = col0 + bj * 128;
                        if constexpr (B16) { const u32x4 w = *(const u32x4*)(hb + (size_t)r * DM + c); b[q][bj][0] = (f32x4){bflo(w.x), bfhi(w.x), bflo(w.y), bfhi(w.y)}; b[q][bj][1] = (f32x4){bflo(w.z), bfhi(w.z), bflo(w.w), bfhi(w.w)}; }
                        else { const float* bp = base + (size_t)r * DM + c; b[q][bj][0] = *(const f32x4*)bp; b[q][bj][1] = *(const f32x4*)(bp + 4); } } }
#pragma unroll
                for (int q = 0; q < 2; ++q) { const int m = 2 * mp + q, r = row0 + ai * 128 + m * 16; float ss = 0.f;
#pragma unroll
                    for (int bj = 0; bj < 2; ++bj) { const int c = col0 + bj * 128;
                        const f32x4 v0 = b[q][bj][0] + scale * acc[ai][bj][m][0], v1 = b[q][bj][1] + scale * acc[ai][bj][m][1];
                        if constexpr (W32) { float* op = out + (size_t)r * DM + c; *(f32x4*)op = v0; *(f32x4*)(op + 4) = v1; }
                        *(u32x4*)(hb + (size_t)r * DM + c) = pack8(v0, v1);
                        ss += (v0[0] * v0[0] + v0[1] * v0[1]) + (v0[2] * v0[2] + v0[3] * v0[3]) + (v1[0] * v1[0] + v1[1] * v1[1]) + (v1[2] * v1[2] + v1[3] * v1[3]); }
                    ss += __shfl_xor(ss, 16); ss += __shfl_xor(ss, 32);
                    if (fq == 0) atomicAdd(rowsq_out + r, f2rq(ss)); }
                asm volatile("" ::: "memory"); }
    }
};
struct EpiFinal {
    static constexpr bool MID = false, PRE = false;
    float* out; const bf16_t* hb; u64* rowsq; unsigned* cnt; const float* gfin;
    __device__ __forceinline__ void operator()(AccRef acc, const Unit& u, int wr, int wc, int fr, int fq, const float (&pre)[8]) const {
        int row0 = u.pm * 256 + wr * 64 + fr; asm volatile("" : "+v"(row0)); const int col0 = u.pn * 256 + wc * 32 + 8 * fq;
#pragma unroll
        for (int ai = 0; ai < 2; ++ai)
#pragma unroll
            for (int mp = 0; mp < 2; ++mp) {
                u32x4 w[2][2];
#pragma unroll
                for (int q = 0; q < 2; ++q)
#pragma unroll
                    for (int bj = 0; bj < 2; ++bj) w[q][bj] = *(const u32x4*)(hb + (size_t)(row0 + ai * 128 + (2 * mp + q) * 16) * DM + col0 + bj * 128);
#pragma unroll
                for (int q = 0; q < 2; ++q) { const int m = 2 * mp + q, r = row0 + ai * 128 + m * 16; float ss = 0.f;
#pragma unroll
                    for (int bj = 0; bj < 2; ++bj) { const u32x4 x = w[q][bj];
                        const f32x4 v0 = (f32x4){bflo(x.x), bfhi(x.x), bflo(x.y), bfhi(x.y)} + 0.5f * acc[ai][bj][m][0], v1 = (f32x4){bflo(x.z), bfhi(x.z), bflo(x.w), bfhi(x.w)} + 0.5f * acc[ai][bj][m][1];
                        ss += (v0[0] * v0[0] + v0[1] * v0[1]) + (v0[2] * v0[2] + v0[3] * v0[3]) + (v1[0] * v1[0] + v1[1] * v1[1]) + (v1[2] * v1[2] + v1[3] * v1[3]); }
                    ss += __shfl_xor(ss, 16); ss += __shfl_xor(ss, 32);
                    if (fq == 0) atomicAdd(rowsq + r, f2rq(ss)); }
                asm volatile("" ::: "memory"); }
        asm volatile("s_waitcnt vmcnt(0)" ::: "memory");
        unsigned* cw = cnt + 64 * u.pm;
        if ((threadIdx.x & 63) == 0) __hip_atomic_fetch_add(cw, 1u, __ATOMIC_RELAXED, __HIP_MEMORY_SCOPE_AGENT);
        { unsigned sp = 0;
          while ((unsigned)__builtin_amdgcn_readfirstlane(__hip_atomic_load(cw, __ATOMIC_RELAXED, __HIP_MEMORY_SCOPE_AGENT)) < 32u) { __builtin_amdgcn_s_sleep(2); if (++sp > (1u << 22)) break; } }
        f32x4 gv[2][2];
#pragma unroll
        for (int bj = 0; bj < 2; ++bj) { gv[bj][0] = *(const f32x4*)(gfin + col0 + bj * 128); gv[bj][1] = *(const f32x4*)(gfin + col0 + bj * 128 + 4); }
        u64 rqv[8];
#pragma unroll
        for (int i = 0; i < 8; ++i) rqv[i] = __hip_atomic_load(rowsq + row0 + (i >> 2) * 128 + (i & 3) * 16, __ATOMIC_RELAXED, __HIP_MEMORY_SCOPE_AGENT);
#pragma unroll
        for (int ai = 0; ai < 2; ++ai)
#pragma unroll
            for (int mp = 0; mp < 2; ++mp) {
                u32x4 w[2][2];
#pragma unroll
                for (int q = 0; q < 2; ++q)
#pragma unroll
                    for (int bj = 0; bj < 2; ++bj) w[q][bj] = *(const u32x4*)(hb + (size_t)(row0 + ai * 128 + (2 * mp + q) * 16) * DM + col0 + bj * 128);
#pragma unroll
                for (int q = 0; q < 2; ++q) { const int m = 2 * mp + q, r = row0 + ai * 128 + m * 16; float* op = out + (size_t)r * DM;
                    const float rs = rsqrtf(rq2f(rqv[ai * 4 + m]) * (1.0f / DM) + 1e-6f);
#pragma unroll
                    for (int bj = 0; bj < 2; ++bj) { const int c = col0 + bj * 128; const u32x4 x = w[q][bj];
                        const f32x4 v0 = (f32x4){bflo(x.x), bfhi(x.x), bflo(x.y), bfhi(x.y)} + 0.5f * acc[ai][bj][m][0], v1 = (f32x4){bflo(x.z), bfhi(x.z), bflo(x.w), bfhi(x.w)} + 0.5f * acc[ai][bj][m][1];
                        *(f32x4*)(op + c) = v0 * rs * gv[bj][0]; *(f32x4*)(op + c + 4) = v1 * rs * gv[bj][1]; } }
                asm volatile("" ::: "memory"); }
    }
};
struct EpiIn {
    static constexpr bool MID = false, PRE = false;
    const u64* rowsq; bf16_t* z; const float* tab;
    __device__ __forceinline__ void prefetch(float (&pre)[8], const Unit& u, int wr, int fr) const {
        const int row0 = u.pm * 256 + wr * 64 + fr;
#pragma unroll
        for (int i = 0; i < 8; ++i) pre[i] = __uint_as_float(rq_lo(rowsq, row0 + (i >> 2) * 128 + (i & 3) * 16));
    }
    __device__ __forceinline__ void operator()(AccRef acc, const Unit& u, int wr, int wc, int fr, int fq, const float (&pre)[8]) const {
        int row0 = u.pm * 256 + wr * 64 + fr; asm volatile("" : "+v"(row0));
        unsigned rq[8];
#pragma unroll
        for (int i = 0; i < 8; ++i) rq[i] = rq_lo(rowsq, row0 + (i >> 2) * 128 + (i & 3) * 16);
        if (u.pn < 4) {
            const bool isq = u.pn < 2; const int hh = wc >> 1, head = (u.pn & 1) * 2 + hh, j0 = 32 * (wc & 1) + 8 * fq;
            const float lg = log2_gamma(head);
#pragma unroll
            for (int ai = 0; ai < 2; ++ai)
#pragma unroll
                for (int mp = 0; mp < 2; ++mp) {
                    f32x4 t[2][4];
#pragma unroll
                    for (int q = 0; q < 2; ++q) { const int r = row0 + ai * 128 + (2 * mp + q) * 16; const int pos = (r & (SEQ - 1)) + NMETA; const f32x4* tp = (const f32x4*)(tab + ((size_t)pos * 64 + j0) * 2);
#pragma unroll
                        for (int k = 0; k < 4; ++k) t[q][k] = tp[k]; }
#pragma unroll
                    for (int q = 0; q < 2; ++q) { const int m = 2 * mp + q, r = row0 + ai * 128 + m * 16; const float rs = rsqrtf(rqlo2f(rq[ai * 4 + m]) * (1.0f / DM) + 1e-6f);
                        const int cidx = (r & (SEQ - 1)) & 127;
                        const float f = rs * (isq ? 0.08838834764831845f * exp2f((float)cidx * lg) : exp2f(-(float)cidx * lg));
                        bf16_t* zp = z + (size_t)r * NIN + u.pn * 256 + hh * 128 + j0;
#pragma unroll
                        for (int n = 0; n < 2; ++n) { const f32x4 ta = t[q][2 * n], tb = t[q][2 * n + 1]; const f32x4 x1 = acc[ai][0][m][n], x2 = acc[ai][1][m][n];
                            u32x2 w1, w2;
                            w1.x = cvt_pk_bf16((x1[0] * ta[0] - x2[0] * ta[1]) * f, (x1[1] * ta[2] - x2[1] * ta[3]) * f); w1.y = cvt_pk_bf16((x1[2] * tb[0] - x2[2] * tb[1]) * f, (x1[3] * tb[2] - x2[3] * tb[3]) * f);
                            w2.x = cvt_pk_bf16((x1[0] * ta[1] + x2[0] * ta[0]) * f, (x1[1] * ta[3] + x2[1] * ta[2]) * f); w2.y = cvt_pk_bf16((x1[2] * tb[1] + x2[2] * tb[0]) * f, (x1[3] * tb[3] + x2[3] * tb[2]) * f);
                            *(u32x2*)(zp + 4 * n) = w1; *(u32x2*)(zp + 64 + 4 * n) = w2; } }
                    asm volatile("" ::: "memory"); }
        } else {
            const int col0 = u.pn * 256 + wc * 32 + 8 * fq;
#pragma unroll
            for (int ai = 0; ai < 2; ++ai)
#pragma unroll
                for (int m = 0; m < 4; ++m) { const int r = row0 + ai * 128 + m * 16; const float rs = rsqrtf(rqlo2f(rq[ai * 4 + m]) * (1.0f / DM) + 1e-6f);
#pragma unroll
                    for (int bj = 0; bj < 2; ++bj) *(u32x4*)(z + (size_t)r * NIN + col0 + bj * 128) = pack8(acc[ai][bj][m][0] * rs, acc[ai][bj][m][1] * rs); }
        }
    }
};
struct EpiMix {
    static constexpr bool MID = true, PRE = false;
    bf16_t* z;
    static __device__ __forceinline__ float cl(float x) { return fminf(fmaxf(x, -30.f), 30.f); }
    __device__ __forceinline__ void mid(f32x4 (&acc)[2][2][4][2], const Unit& u, int wr, int wc, int fr, int fq) const {
        int row0 = u.pm * 256 + wr * 64 + fr; const int col0 = u.pn * 256 + wc * 32 + 8 * fq;
        asm volatile("" : "+v"(row0));
#pragma unroll
        for (int ai = 0; ai < 2; ++ai)
#pragma unroll
            for (int mp = 0; mp < 2; ++mp) {
                u32x4 ga[2][2], gb[2][2];
#pragma unroll
                for (int q = 0; q < 2; ++q) { const int r = row0 + ai * 128 + (2 * mp + q) * 16;
#pragma unroll
                    for (int bj = 0; bj < 2; ++bj) { const bf16_t* gp = z + (size_t)r * NIN + 2560 + col0 + bj * 128; ga[q][bj] = *(const u32x4*)gp; gb[q][bj] = *(const u32x4*)(gp + 1024); } }
#pragma unroll
                for (int q = 0; q < 2; ++q) { const int m = 2 * mp + q;
#pragma unroll
                    for (int bj = 0; bj < 2; ++bj)
#pragma unroll
                        for (int i = 0; i < 4; ++i) { const unsigned wa = ga[q][bj][i], wb = gb[q][bj][i];
                            const float r0 = (1.0f + expneg(cl(bflo(wb)))) * fast_rcp(1.0f + expneg(cl(bflo(wa))));
                            const float r1 = (1.0f + expneg(cl(bfhi(wb)))) * fast_rcp(1.0f + expneg(cl(bfhi(wa))));
                            acc[ai][bj][m][i >> 1][(i & 1) * 2] *= r0; acc[ai][bj][m][i >> 1][(i & 1) * 2 + 1] *= r1; } }
                asm volatile("" ::: "memory"); }
    }
    __device__ __forceinline__ void operator()(AccRef acc, const Unit& u, int wr, int wc, int fr, int fq, const float (&pre)[8]) const {
        const int row0 = u.pm * 256 + wr * 64 + fr, col0 = u.pn * 256 + wc * 32 + 8 * fq;
#pragma unroll
        for (int ai = 0; ai < 2; ++ai) {
            u32x4 gb[4][2];
#pragma unroll
            for (int m = 0; m < 4; ++m)
#pragma unroll
                for (int bj = 0; bj < 2; ++bj) gb[m][bj] = *(const u32x4*)(z + (size_t)(row0 + ai * 128 + m * 16) * NIN + 3584 + col0 + bj * 128);
#pragma unroll
            for (int m = 0; m < 4; ++m) { const int r = row0 + ai * 128 + m * 16;
#pragma unroll
                for (int bj = 0; bj < 2; ++bj) { const u32x4 g = gb[m][bj]; f32x4 o0, o1;
                    o0[0] = acc[ai][bj][m][0][0] * fast_rcp(1.0f + expneg(cl(bflo(g[0])))); o0[1] = acc[ai][bj][m][0][1] * fast_rcp(1.0f + expneg(cl(bfhi(g[0]))));
                    o0[2] = acc[ai][bj][m][0][2] * fast_rcp(1.0f + expneg(cl(bflo(g[1])))); o0[3] = acc[ai][bj][m][0][3] * fast_rcp(1.0f + expneg(cl(bfhi(g[1]))));
                    o1[0] = acc[ai][bj][m][1][0] * fast_rcp(1.0f + expneg(cl(bflo(g[2])))); o1[1] = acc[ai][bj][m][1][1] * fast_rcp(1.0f + expneg(cl(bfhi(g[2]))));
                    o1[2] = acc[ai][bj][m][1][2] * fast_rcp(1.0f + expneg(cl(bflo(g[3])))); o1[3] = acc[ai][bj][m][1][3] * fast_rcp(1.0f + expneg(cl(bfhi(g[3]))));
                    *(u32x4*)(z + (size_t)r * NIN + 1024 + col0 + bj * 128) = pack8(o0, o1); } }
            asm volatile("" ::: "memory"); }
    }
};

struct SkArgs { const bf16_t* A; int lda; const bf16_t* Bt; int K; const u64* rowsq_in; u64* rowsq_out; float* hmeta; bf16_t* hb; bf16_t* z; const float* tab; float scale; };
template <int MODE>
__device__ __forceinline__ void skinny(LAS unsigned char* lds, const SkArgs a) {
    int tid_ = threadIdx.x; asm volatile("" : "+v"(tid_));
    const int tid = tid_, lane = tid & 63, wave = __builtin_amdgcn_readfirstlane(tid >> 6), l15 = lane & 15, g = lane >> 4;
    constexpr int NITEMS = MODE == 0 ? 176 : (MODE == 2 ? 256 : 64);
    const int K = a.K;
    LAS f32x4* red = (LAS f32x4*)lds;
    for (int it = blockIdx.x; it < NITEMS; it += gridDim.x) {
        int brow0 = 16 * it, brow1 = 0; bool pair = false;
        if (MODE == 0) { const int hid = 16 * it; brow0 = ((hid >> 7) << 8) + (hid & 127); brow1 = brow0 + 128; pair = true; }
        if (MODE == 2) { if (it < 32) { brow0 = ((it >> 3) << 8) + (((it >> 2) & 1) << 6) + 16 * (it & 3); brow1 = brow0 + 128; pair = true; } else brow0 = 1024 + 16 * (it - 32); }
        int kb, ke;
        if (MODE == 3) { kb = (wave >> 2) * 512 + (wave & 3) * 128; ke = kb + 128; } else { const int kper = K >> 3; kb = wave * kper; ke = kb + kper; }
        f32x4 acc0 = (f32x4){0.f, 0.f, 0.f, 0.f}, acc1 = (f32x4){0.f, 0.f, 0.f, 0.f};
        const bf16_t* ap = a.A + (size_t)l15 * a.lda + 8 * g;
        const bf16_t* bp0 = a.Bt + (size_t)(brow0 + l15) * K + 8 * g;
        const bf16_t* bp1 = a.Bt + (size_t)(brow1 + l15) * K + 8 * g;
#pragma unroll 1
        for (int k = kb; k < ke; k += 128) { bf16x8 av[4], b0[4], b1[4];
#pragma unroll
            for (int q = 0; q < 4; ++q) { const int kk = (k + 32 * q < ke) ? k + 32 * q : kb; av[q] = *(const bf16x8*)(ap + kk); b0[q] = *(const bf16x8*)(bp0 + kk); b1[q] = *(const bf16x8*)(bp1 + kk); }
#pragma unroll
            for (int q = 0; q < 4; ++q) if (k + 32 * q < ke) { acc0 = __builtin_amdgcn_mfma_f32_16x16x32_bf16(av[q], b0[q], acc0, 0, 0, 0); acc1 = __builtin_amdgcn_mfma_f32_16x16x32_bf16(av[q], b1[q], acc1, 0, 0, 0); } }
        red[(wave * 2 + 0) * 64 + lane] = acc0; red[(wave * 2 + 1) * 64 + lane] = acc1;
        __syncthreads();
        if (wave == 0) {
            f32x4 v0 = (f32x4){0.f, 0.f, 0.f, 0.f}, v1 = (f32x4){0.f, 0.f, 0.f, 0.f};
            if (MODE == 3) { for (int w = 0; w < 4; ++w) { v0 += red[(w * 2) * 64 + lane]; v1 += red[((w + 4) * 2) * 64 + lane]; } }
            else { for (int w = 0; w < 8; ++w) { v0 += red[(w * 2) * 64 + lane]; v1 += red[(w * 2 + 1) * 64 + lane]; } }
#pragma unroll
            for (int r = 0; r < 4; ++r) { const int row = 4 * g + r; const size_t R = (size_t)(TS + row);
                if (MODE == 0) { const float rs = rsqrtf(rq2f(a.rowsq_in[TS + row]) * (1.0f / DM) + 1e-6f);
                    a.z[R * FF + 16 * it + l15] = (bf16_t)(cvt_pk_bf16(silu_f(v0[r] * rs) * (v1[r] * rs), 0.f) & 0xffffu); }
                if (MODE == 1) { const int col = 16 * it + l15; const float hn = a.hmeta[(size_t)row * DM + col] + a.scale * v0[r];
                    a.hmeta[(size_t)row * DM + col] = hn; a.hb[R * DM + col] = (bf16_t)(cvt_pk_bf16(hn, 0.f) & 0xffffu);
                    float ss = hn * hn; ss += __shfl_xor(ss, 1); ss += __shfl_xor(ss, 2); ss += __shfl_xor(ss, 4); ss += __shfl_xor(ss, 8);
                    if (l15 == 0) atomicAdd(a.rowsq_out + TS + row, f2rq(ss)); }
                if (MODE == 2) { const float rs = rsqrtf(rq2f(a.rowsq_in[TS + row]) * (1.0f / DM) + 1e-6f);
                    if (it < 32) { const int pn = it >> 3, hh = (it >> 2) & 1, j = 16 * (it & 3) + l15, head = (pn & 1) * 2 + hh; const float lg = log2_gamma(head); const float cidx = (float)(112 + row);
                        const float f = rs * (pn < 2 ? 0.08838834764831845f * exp2f(cidx * lg) : exp2f(-cidx * lg));
                        const float c = a.tab[((size_t)row * 64 + j) * 2], sn = a.tab[((size_t)row * 64 + j) * 2 + 1];
                        bf16_t* zp = a.z + R * NIN + pn * 256 + hh * 128 + j;
                        zp[0] = (bf16_t)(cvt_pk_bf16((v0[r] * c - v1[r] * sn) * f, 0.f) & 0xffffu); zp[64] = (bf16_t)(cvt_pk_bf16((v0[r] * sn + v1[r] * c) * f, 0.f) & 0xffffu); }
                    else a.z[R * NIN + brow0 + l15] = (bf16_t)(cvt_pk_bf16(v0[r] * rs, 0.f) & 0xffffu); }
                if (MODE == 3) { const int col = 16 * it + l15; const float ga = bf2f(a.z[R * NIN + 2560 + col]), gb = bf2f(a.z[R * NIN + 3584 + col]);
                    const float mx = v0[r] * fast_rcp(1.0f + expneg(ga)) + v1[r] * fast_rcp(1.0f + expneg(gb));
                    a.z[R * NIN + 1024 + col] = (bf16_t)(cvt_pk_bf16(mx, 0.f) & 0xffffu); } }
        }
        __syncthreads();
    }
}

__device__ __forceinline__ int maprow(int map, int n) {
    if (map == 1) return ((n >> 7) << 8) + (n & 127);
    if (map == 2) return ((n >> 7) << 8) + 128 + (n & 127);
    if (map == 3) { if (n >= 1024) return n; const int pn = n >> 8, hh = (n >> 7) & 1, half = (n >> 6) & 1, j = n & 63; return (pn << 8) + (half << 7) + (hh << 6) + j; }
    return n;
}
__device__ __forceinline__ void conv_item(const float* src, int N, const float* gain, bf16_t* dst, int ldd, int koff, int map, int item, LAS float* scr, int lane) {
    const int nblk = N / 32, kb = item / nblk, nb = item % nblk, k0 = 64 * kb, n0 = 32 * nb;
    { f32x4 v[8]; const int kr = lane >> 3, n4 = lane & 7;
#pragma unroll
      for (int i = 0; i < 8; ++i) v[i] = *(const f32x4*)(src + (size_t)(k0 + 8 * i + kr) * N + n0 + 4 * n4);
#pragma unroll
      for (int i = 0; i < 8; ++i) { const int kk = 8 * i + kr; const float gg = gain ? gain[k0 + kk] : 1.0f; LAS float* d = scr + kk * 33 + 4 * n4;
          d[0] = v[i][0] * gg; d[1] = v[i][1] * gg; d[2] = v[i][2] * gg; d[3] = v[i][3] * gg; } }
    asm volatile("s_waitcnt lgkmcnt(0)" ::: "memory");
    const int c = lane & 7;
#pragma unroll
    for (int j = 0; j < 4; ++j) { const int n = (lane >> 3) + 8 * j; const LAS float* s = scr + (8 * c) * 33 + n;
        u32x4 o; o.x = cvt_pk_bf16(s[0 * 33], s[1 * 33]); o.y = cvt_pk_bf16(s[2 * 33], s[3 * 33]); o.z = cvt_pk_bf16(s[4 * 33], s[5 * 33]); o.w = cvt_pk_bf16(s[6 * 33], s[7 * 33]);
        *(u32x4*)(dst + (size_t)maprow(map, n0 + n) * ldd + koff + k0 + 8 * c) = o; }
    asm volatile("s_waitcnt lgkmcnt(0)" ::: "memory");
}
__device__ __forceinline__ void weff_item(const float* maps, const float* scale, const float* wp, bf16_t* dst, int item, int lane) {
    const int ab = item >> 4, nb = item & 15, i0 = 16 * ab, g = i0 >> 7, a0 = i0 & 127, n = 64 * nb + lane;
    const float* mp = maps + ((size_t)g * 128 + a0) * 128; const float* sc = scale + g * 128; const float* wc = wp + (size_t)(g * 128) * DM + n;
    float s[16];
#pragma unroll
    for (int a = 0; a < 16; ++a) s[a] = 0.f;
    for (int j = 0; j < 128; j += 4) {
        const float w0 = sc[j] * wc[(size_t)j * DM], w1 = sc[j + 1] * wc[(size_t)(j + 1) * DM], w2 = sc[j + 2] * wc[(size_t)(j + 2) * DM], w3 = sc[j + 3] * wc[(size_t)(j + 3) * DM];
#pragma unroll
        for (int a = 0; a < 16; ++a) { const float* m = mp + a * 128 + j; s[a] += m[0] * w0 + m[1] * w1 + m[2] * w2 + m[3] * w3; }
    }
    u32x4 o0, o1;
    o0.x = cvt_pk_bf16(s[0], s[1]); o0.y = cvt_pk_bf16(s[2], s[3]); o0.z = cvt_pk_bf16(s[4], s[5]); o0.w = cvt_pk_bf16(s[6], s[7]);
    o1.x = cvt_pk_bf16(s[8], s[9]); o1.y = cvt_pk_bf16(s[10], s[11]); o1.z = cvt_pk_bf16(s[12], s[13]); o1.w = cvt_pk_bf16(s[14], s[15]);
    bf16_t* d = dst + (size_t)n * DM + 512 + i0;
    *(u32x4*)d = o0; *(u32x4*)(d + 8) = o1;
}
__device__ __forceinline__ void row_to_bf16(const float* xrow, bf16_t* hbrow, float* hmrow, u64* rsq, int lane, bool zero) {
    f32x4 v[4]; float s = 0.f;
#pragma unroll
    for (int j = 0; j < 4; ++j) { v[j] = zero ? (f32x4){0.f, 0.f, 0.f, 0.f} : ((const f32x4*)xrow)[lane + 64 * j]; s += (v[j][0] * v[j][0] + v[j][1] * v[j][1]) + (v[j][2] * v[j][2] + v[j][3] * v[j][3]); }
    s = wave_sum(s);
#pragma unroll
    for (int j = 0; j < 4; ++j) { u32x2 w; w.x = cvt_pk_bf16(v[j][0], v[j][1]); w.y = cvt_pk_bf16(v[j][2], v[j][3]); ((u32x2*)hbrow)[lane + 64 * j] = w; if (hmrow) ((f32x4*)hmrow)[lane + 64 * j] = v[j]; }
    if (lane == 0) *rsq = f2rq(s);
}
__device__ __forceinline__ void phase_prep(const Params& P, LAS unsigned char* lds) {
    int tid_ = threadIdx.x; asm volatile("" : "+v"(tid_));
    const int tid = tid_, lane = tid & 63, wave = tid >> 6;
    const int gw = blockIdx.x * 8 + wave, NGW = gridDim.x * 8;
    LAS float* scr = (LAS float*)(lds + wave * 8448);
    unsigned char* ws = P.ws;
    constexpr int I_G = 16 * 88, I_D = 44 * 32, I_IN = 16 * 144, I_R = 8 * 32, I_O = 16 * 32;
    constexpr int PER_LAYER = 6 * I_G + I_IN + I_R + I_O;
    static_assert(I_G == I_D, "item counts");
    constexpr int NITEMS = 1024 + 2 * PER_LAYER;
    for (int it = gw; it < NITEMS; it += NGW) {
        if (it < 1024) { const int l = it >> 9, r = it & 511;
            weff_item(P.in[8] + (size_t)l * 4 * 128 * 128, P.in[9] + (size_t)l * 512, P.in[11] + (size_t)l * 512 * DM, (bf16_t*)(ws + WS_W + l * W_LAYER + W_WRP), r, lane); continue; }
        int r = it - 1024; const int l = r / PER_LAYER; r -= l * PER_LAYER;
        unsigned char* wl = ws + WS_W + l * W_LAYER;
        const float* n1 = P.in[2] + (size_t)l * DM; const float* nm = P.in[6] + (size_t)l * DM; const float* n2 = P.in[13] + (size_t)l * DM;
        if (r < I_G) { conv_item(P.in[3] + (size_t)l * DM * FF, FF, n1, (bf16_t*)(wl + W_W1), DM, 0, 1, r, scr, lane); continue; } r -= I_G;
        if (r < I_G) { conv_item(P.in[4] + (size_t)l * DM * FF, FF, n1, (bf16_t*)(wl + W_W1), DM, 0, 2, r, scr, lane); continue; } r -= I_G;
        if (r < I_D) { conv_item(P.in[5] + (size_t)l * FF * DM, DM, nullptr, (bf16_t*)(wl + W_W1D), FF, 0, 0, r, scr, lane); continue; } r -= I_D;
        if (r < I_IN) { conv_item(P.in[7] + (size_t)l * DM * NIN, NIN, nm, (bf16_t*)(wl + W_WIN), DM, 0, 3, r, scr, lane); continue; } r -= I_IN;
        if (r < I_R) { conv_item(P.in[10] + (size_t)l * 512 * DM, DM, nullptr, (bf16_t*)(wl + W_WRP), DM, 0, 0, r, scr, lane); continue; } r -= I_R;
        if (r < I_O) { conv_item(P.in[12] + (size_t)l * DM * DM, DM, nullptr, (bf16_t*)(wl + W_WO), DM, 0, 0, r, scr, lane); continue; } r -= I_O;
        if (r < I_G) { conv_item(P.in[14] + (size_t)l * DM * FF, FF, n2, (bf16_t*)(wl + W_W2), DM, 0, 1, r, scr, lane); continue; } r -= I_G;
        if (r < I_G) { conv_item(P.in[15] + (size_t)l * DM * FF, FF, n2, (bf16_t*)(wl + W_W2), DM, 0, 2, r, scr, lane); continue; } r -= I_G;
        conv_item(P.in[16] + (size_t)l * FF * DM, DM, nullptr, (bf16_t*)(wl + W_W2D), FF, 0, 0, r, scr, lane);
    }
    u64* rowsq = (u64*)(ws + WS_ROWSQ); bf16_t* hb = (bf16_t*)(ws + WS_HB); float* hmeta = (float*)(ws + WS_HMETA);
    for (int m = 2 * gw; m < TS; m += 2 * NGW) {
        const int m2 = m + 1; const f32x4* xa = (const f32x4*)(P.in[0] + (size_t)m * DM); const f32x4* xb = (const f32x4*)(P.in[0] + (size_t)m2 * DM);
        f32x4 va[4], vb[4]; float sa = 0.f, sb = 0.f;
#pragma unroll
        for (int j = 0; j < 4; ++j) { va[j] = xa[lane + 64 * j]; vb[j] = xb[lane + 64 * j]; }
#pragma unroll
        for (int j = 0; j < 4; ++j) { sa += (va[j][0] * va[j][0] + va[j][1] * va[j][1]) + (va[j][2] * va[j][2] + va[j][3] * va[j][3]); sb += (vb[j][0] * vb[j][0] + vb[j][1] * vb[j][1]) + (vb[j][2] * vb[j][2] + vb[j][3] * vb[j][3]); }
        sa = wave_sum(sa); sb = wave_sum(sb);
#pragma unroll
        for (int j = 0; j < 4; ++j) { u32x2 wa, wb; wa.x = cvt_pk_bf16(va[j][0], va[j][1]); wa.y = cvt_pk_bf16(va[j][2], va[j][3]); wb.x = cvt_pk_bf16(vb[j][0], vb[j][1]); wb.y = cvt_pk_bf16(vb[j][2], vb[j][3]);
            ((u32x2*)(hb + (size_t)m * DM))[lane + 64 * j] = wa; ((u32x2*)(hb + (size_t)m2 * DM))[lane + 64 * j] = wb; }
        if (lane == 0) { rowsq[m] = f2rq(sa); rowsq[m2] = f2rq(sb); } }
    for (int m = gw; m < NMETA; m += NGW) row_to_bf16(P.in[1] + (size_t)m * DM, hb + (size_t)(TS + m) * DM, hmeta + (size_t)m * DM, rowsq + TS + m, lane, false);
    const int gt = blockIdx.x * 512 + tid, NGT = gridDim.x * 512;
    for (int i = gt; i < 6 * TM; i += NGT) rowsq[TM + i] = 0ull;
    { unsigned* cnt = (unsigned*)(ws + WS_CNT); for (int i = gt; i < 128 * 64; i += NGT) cnt[i] = 0u; }
    float* tab = (float*)(ws + WS_TAB);
    for (int i = gt; i < NPOS * 64; i += NGT) { const int pos = i >> 6, j = i & 63;
        const double inv = exp2(-(double)j * (13.287712379549449 / 64.0)); const double ang = (double)pos * inv;
        const double k = rint(ang * 0.15915494309189535); const float rr = (float)(ang - k * 6.283185307179586);
        tab[2 * i] = cosf(rr); tab[2 * i + 1] = sinf(rr); }
}

__device__ __forceinline__ unsigned offb(unsigned row, unsigned ch) { return 256u * row + 16u * (ch ^ (((row & 3) << 2) | ((row >> 2) & 3))); }
__device__ __forceinline__ unsigned row_addr16(unsigned lane, unsigned rb, unsigned s) { return offb((lane & 15) + 16 * rb, 4 * s + (lane >> 4)); }
__device__ __forceinline__ unsigned tr_addr16(unsigned lane, unsigned c, unsigned ks, unsigned t) { const unsigned g = lane >> 4, q = (lane & 15) >> 2, p = lane & 3; return offb(32 * ks + 8 * g + 4 * t + q, 2 * c + (p >> 1)) + 8 * (p & 1); }
__device__ __forceinline__ bf16x8 tr_frag(unsigned tile, unsigned lane, unsigned c, unsigned ks) {
    u32x2 r0, r1; const unsigned a0 = tile + tr_addr16(lane, c, ks, 0), a1 = tile + tr_addr16(lane, c, ks, 1);
    asm volatile("ds_read_b64_tr_b16 %0, %2\n\tds_read_b64_tr_b16 %1, %3\n\ts_waitcnt lgkmcnt(0)" : "=&v"(r0), "=&v"(r1) : "v"(a0), "v"(a1) : "memory");
    u32x4 w; w.x = r0.x; w.y = r0.y; w.z = r1.x; w.w = r1.y; return __builtin_bit_cast(bf16x8, w);
}
__device__ __forceinline__ void tr_frag8(unsigned tile, unsigned lane, unsigned ks, bf16x8 (&f)[8]) {
    u32x2 r[16]; unsigned a[16];
#pragma unroll
    for (int c = 0; c < 8; ++c) { a[2 * c] = tile + tr_addr16(lane, c, ks, 0); a[2 * c + 1] = tile + tr_addr16(lane, c, ks, 1); }
    asm volatile("ds_read_b64_tr_b16 %0, %16\n\tds_read_b64_tr_b16 %1, %17\n\tds_read_b64_tr_b16 %2, %18\n\tds_read_b64_tr_b16 %3, %19\n\t"
                 "ds_read_b64_tr_b16 %4, %20\n\tds_read_b64_tr_b16 %5, %21\n\tds_read_b64_tr_b16 %6, %22\n\tds_read_b64_tr_b16 %7, %23\n\t"
                 "ds_read_b64_tr_b16 %8, %24\n\tds_read_b64_tr_b16 %9, %25\n\tds_read_b64_tr_b16 %10, %26\n\tds_read_b64_tr_b16 %11, %27\n\t"
                 "ds_read_b64_tr_b16 %12, %28\n\tds_read_b64_tr_b16 %13, %29\n\tds_read_b64_tr_b16 %14, %30\n\tds_read_b64_tr_b16 %15, %31\n\ts_waitcnt lgkmcnt(0)"
                 : "=&v"(r[0]), "=&v"(r[1]), "=&v"(r[2]), "=&v"(r[3]), "=&v"(r[4]), "=&v"(r[5]), "=&v"(r[6]), "=&v"(r[7]),
                   "=&v"(r[8]), "=&v"(r[9]), "=&v"(r[10]), "=&v"(r[11]), "=&v"(r[12]), "=&v"(r[13]), "=&v"(r[14]), "=&v"(r[15])
                 : "v"(a[0]), "v"(a[1]), "v"(a[2]), "v"(a[3]), "v"(a[4]), "v"(a[5]), "v"(a[6]), "v"(a[7]),
                   "v"(a[8]), "v"(a[9]), "v"(a[10]), "v"(a[11]), "v"(a[12]), "v"(a[13]), "v"(a[14]), "v"(a[15]) : "memory");
#pragma unroll
    for (int c = 0; c < 8; ++c) { u32x4 w; w.x = r[2 * c].x; w.y = r[2 * c].y; w.z = r[2 * c + 1].x; w.w = r[2 * c + 1].y; f[c] = __builtin_bit_cast(bf16x8, w); }
}
__device__ __forceinline__ bf16x8 row_frag(LAS unsigned char* tile, unsigned lane, unsigned rb, unsigned s) { return *(const LAS bf16x8*)(tile + row_addr16(lane, rb, s)); }

__device__ __forceinline__ void stage_ztile(const bf16_t* z, int b, int n, int cb, LAS unsigned char* tile, int tid) {
#pragma unroll
    for (int pass = 0; pass < 4; ++pass) { const int idx = tid + 512 * pass, row = idx >> 4, ch = idx & 15, p = n * 128 + row - 112;
        u32x4 v = *(const u32x4*)(z + (size_t)zrow_of(b, p < 0 ? 0 : p) * NIN + cb + ch * 8);
        if (p < 0) v = (u32x4){0u, 0u, 0u, 0u};
        *(LAS u32x4*)(tile + offb(row, ch)) = v; }
}
template <bool META> __device__ __forceinline__ void phase_ret(const Params& P, LAS unsigned char* lds);
template <bool LOWREG>
__device__ __forceinline__ void kv_compute(unsigned lbase_k, unsigned lbase_v, bf16_t* dst, int h, int lane, int wave) {
    const float g127 = exp2f(127.0f * log2_gamma(h));
    if constexpr (!LOWREG) {
        f32x4 acc[8];
#pragma unroll
        for (int i = 0; i < 8; ++i) acc[i] = (f32x4){0.f, 0.f, 0.f, 0.f};
#pragma unroll 1
        for (int ks = 0; ks < 4; ++ks) { const bf16x8 a = tr_frag(lbase_k, lane, wave, ks); bf16x8 vf[8]; tr_frag8(lbase_v, lane, ks, vf);
#pragma unroll
            for (int eb = 0; eb < 8; ++eb) acc[eb] = __builtin_amdgcn_mfma_f32_16x16x32_bf16(a, vf[eb], acc[eb], 0, 0, 0); }
#pragma unroll
        for (int eb = 0; eb < 8; ++eb) { u32x2 w; w.x = cvt_pk_bf16(acc[eb][0] * g127, acc[eb][1] * g127); w.y = cvt_pk_bf16(acc[eb][2] * g127, acc[eb][3] * g127);
            *(u32x2*)(dst + (size_t)(16 * eb + (lane & 15)) * 128 + 16 * wave + 4 * (lane >> 4)) = w; }
    } else {
#pragma unroll 1
        for (int eb = 0; eb < 8; ++eb) { f32x4 acc = (f32x4){0.f, 0.f, 0.f, 0.f};
#pragma unroll 1
            for (int ks = 0; ks < 4; ++ks) acc = __builtin_amdgcn_mfma_f32_16x16x32_bf16(tr_frag(lbase_k, lane, wave, ks), tr_frag(lbase_v, lane, eb, ks), acc, 0, 0, 0);
            u32x2 w; w.x = cvt_pk_bf16(acc[0] * g127, acc[1] * g127); w.y = cvt_pk_bf16(acc[2] * g127, acc[3] * g127);
            *(u32x2*)(dst + (size_t)(16 * eb + (lane & 15)) * 128 + 16 * wave + 4 * (lane >> 4)) = w; }
    }
}
__device__ __forceinline__ void phase_kv(const Params& P, LAS unsigned char* lds) {
    int tid_ = threadIdx.x; asm volatile("" : "+v"(tid_));
    const int tid = tid_, lane = tid & 63, wave = __builtin_amdgcn_readfirstlane(tid >> 6);
    const bf16_t* z = (const bf16_t*)(P.ws + WS_Z); bf16_t* G = (bf16_t*)(P.ws + WS_G);
    const unsigned lbase = (unsigned)(uintptr_t)lds;
    for (int it = blockIdx.x; it < 224; it += gridDim.x) {
        const int grp = it % 7, h = (it / 7) & 3, b = it / 28;
        const float lg = log2_gamma(h), cd = exp2f(128.0f * lg), g127 = exp2f(127.0f * lg);
        f32x4 acc[8];
#pragma unroll
        for (int i = 0; i < 8; ++i) acc[i] = (f32x4){0.f, 0.f, 0.f, 0.f};
#pragma unroll 1
        for (int j = 0; j < 4; ++j) { const int n = 4 * grp + 1 + j;
            stage_ztile(z, b, n, 512 + h * 128, lds, tid);
            stage_ztile(z, b, n, 1024 + h * 128, lds + 32768, tid);
            __syncthreads();
#pragma unroll
            for (int i = 0; i < 8; ++i) acc[i] = acc[i] * cd;
#pragma unroll 1
            for (int ks = 0; ks < 4; ++ks) { const bf16x8 a = tr_frag(lbase, lane, wave, ks); bf16x8 vf[8]; tr_frag8(lbase + 32768, lane, ks, vf);
#pragma unroll
                for (int eb = 0; eb < 8; ++eb) acc[eb] = __builtin_amdgcn_mfma_f32_16x16x32_bf16(a, vf[eb], acc[eb], 0, 0, 0); }
            __syncthreads(); }
        bf16_t* dst = G + ((size_t)((b * 4 + h) * 8 + grp)) * 16384;
#pragma unroll
        for (int eb = 0; eb < 8; ++eb) { u32x2 w; w.x = cvt_pk_bf16(acc[eb][0] * g127, acc[eb][1] * g127); w.y = cvt_pk_bf16(acc[eb][2] * g127, acc[eb][3] * g127);
            *(u32x2*)(dst + (size_t)(16 * eb + (lane & 15)) * 128 + 16 * wave + 4 * (lane >> 4)) = w; }
    }
    phase_ret<true>(P, lds);
}
template <int W> __device__ __forceinline__ void pool_part(bf16_t* z, int b, int n, int h, int tid) {
    const int j = tid & 127, qd = tid >> 7, colu = 2048 + h * 128 + j;
    constexpr int SB = 8;
#pragma unroll 1
    for (int sb = 0; sb < 32 / SB; ++sb) {
        const int p0 = n * 128 - 112 + 32 * qd + SB * sb;
        float u[SB + W - 1];
#pragma unroll
        for (int i = 0; i < SB + W - 1; ++i) { const int p = p0 - (W - 1) + i; const float v = bf2f(z[(size_t)zrow_of(b, p < 0 ? 0 : p) * NIN + colu]); u[i] = p >= 0 ? v : 0.f; }
        float sum = 0.f;
#pragma unroll
        for (int i = 0; i < W - 1; ++i) sum += u[i];
        float o[SB];
#pragma unroll
        for (int t = 0; t < SB; ++t) { const int p = p0 + t; const float ut = u[t + W - 1]; sum += ut;
            const float mean = (p + 1 < W) ? sum / (float)(p + 1 > 0 ? p + 1 : 1) : sum * (1.0f / (float)W);
            o[t] = mean - ut; sum -= u[t]; }
#pragma unroll
        for (int t = 0; t < SB; ++t) { const int p = p0 + t; if (p >= 0) z[(size_t)zrow_of(b, p) * NIN + 512 + h * 128 + j] = (bf16_t)(cvt_pk_bf16(o[t], 0.f) & 0xffffu); }
    }
}
template <bool META> __device__ __forceinline__ void phase_ret(const Params& P, LAS unsigned char* lds) {
    int tid_ = threadIdx.x; asm volatile("" : "+v"(tid_));
    const int tid = tid_, lane = tid & 63, wave = __builtin_amdgcn_readfirstlane(tid >> 6), g = lane >> 4, l15 = lane & 15;
    bf16_t* z = (bf16_t*)(P.ws + WS_Z); const bf16_t* G = (const bf16_t*)(P.ws + WS_G);
    const unsigned lbase = (unsigned)(uintptr_t)lds;
    LAS unsigned char* tq = lds; LAS unsigned char* tk = lds + 32768; LAS unsigned char* tst = lds + 98304;
    const int it_first = META ? (int)blockIdx.x - ((int)gridDim.x - 4) + 1024 : (int)blockIdx.x, it_end = META ? ((int)blockIdx.x >= (int)gridDim.x - 4 ? it_first + 1 : 0) : 256;
    for (int it = it_first; it < it_end; it += gridDim.x) {
        int grp, h, b; if (!META) { grp = it & 7; h = (it >> 3) & 3; b = it >> 5; } else { grp = 0; b = 0; h = it - 1024; asm volatile("" : "+s"(grp), "+s"(b)); }
        const float lg = log2_gamma(h), cd = exp2f(128.0f * lg);
        {
          const float gam = exp2f(lg); const bf16_t* kv0 = (const bf16_t*)(P.ws + WS_KV0) + (size_t)h * 16384; const bf16_t* gb = G + ((size_t)((b * 4 + h) * 8)) * 16384;
#pragma unroll 1
          for (int pass = 0; pass < 4; ++pass) { const int idx = tid + 512 * pass, row = idx >> 4, ch = idx & 15;
              float a[8];
#pragma unroll
              for (int i = 0; i < 8; ++i) a[i] = 0.f;
              if (!META) {
                  { const u32x4 v = *(const u32x4*)(kv0 + row * 128 + ch * 8); const float w = gam * exp2f(512.0f * lg * (float)grp);
#pragma unroll
                    for (int i = 0; i < 4; ++i) { a[2 * i] += w * bflo(v[i]); a[2 * i + 1] += w * bfhi(v[i]); } }
                  for (int gp = 0; gp < grp; ++gp) { const u32x4 v = *(const u32x4*)(gb + (size_t)gp * 16384 + row * 128 + ch * 8); const float w = gam * exp2f(512.0f * lg * (float)(grp - 1 - gp));
#pragma unroll
                    for (int i = 0; i < 4; ++i) { a[2 * i] += w * bflo(v[i]); a[2 * i + 1] += w * bfhi(v[i]); } } }
              u32x4 o; o.x = cvt_pk_bf16(a[0], a[1]); o.y = cvt_pk_bf16(a[2], a[3]); o.z = cvt_pk_bf16(a[4], a[5]); o.w = cvt_pk_bf16(a[6], a[7]);
              *(LAS u32x4*)(tst + offb(row, ch)) = o; } }
#pragma unroll 1
        for (int j = 0; j < (META ? 1 : 4); ++j) {
        const int n = META ? 0 : 4 * grp + 1 + j;
        stage_ztile(z, b, n, h * 128, tq, tid);
        stage_ztile(z, b, n, 512 + h * 128, tk, tid);
        stage_ztile(z, b, n, 1024 + h * 128, lds + 65536, tid);
        __syncthreads();
        f32x4 acc2[8];
#pragma unroll
        for (int i = 0; i < 8; ++i) acc2[i] = (f32x4){0.f, 0.f, 0.f, 0.f};
        const bool upd = !META && (j < 3);
        if (upd) {
#pragma unroll 1
            for (int ks = 0; ks < 4; ++ks) { const bf16x8 a = tr_frag(lbase + 32768, lane, wave, ks); bf16x8 vf[8]; tr_frag8(lbase + 65536, lane, ks, vf);
#pragma unroll
                for (int eb = 0; eb < 8; ++eb) acc2[eb] = __builtin_amdgcn_mfma_f32_16x16x32_bf16(a, vf[eb], acc2[eb], 0, 0, 0); } }
        if constexpr (META) kv_compute<true>(lbase + 32768, lbase + 65536, (bf16_t*)(P.ws + WS_KV0) + (size_t)h * 16384, h, lane, wave);
        switch (h) { case 0: pool_part<2>(z, b, n, h, tid); break; case 1: pool_part<4>(z, b, n, h, tid); break; case 2: pool_part<8>(z, b, n, h, tid); break; default: pool_part<16>(z, b, n, h, tid); break; }
        f32x4 acc[8];
#pragma unroll
        for (int i = 0; i < 8; ++i) acc[i] = (f32x4){0.f, 0.f, 0.f, 0.f};
        {
        bf16x8 qc[4];
#pragma unroll
        for (int ks = 0; ks < 4; ++ks) qc[ks] = row_frag(tq, lane, wave, ks);
#pragma unroll
        for (int ks = 0; ks < 4; ++ks) {
#pragma unroll
            for (int eb = 0; eb < 8; ++eb) acc[eb] = __builtin_amdgcn_mfma_f32_16x16x32_bf16(qc[ks], row_frag(tst, lane, eb, ks), acc[eb], 0, 0, 0);
            __builtin_amdgcn_sched_barrier(0); }
        }
        if (upd) {
            __syncthreads();
#pragma unroll
            for (int eb = 0; eb < 8; ++eb) { LAS u32x2* tp = (LAS u32x2*)(tst + offb(16 * eb + l15, 2 * wave + (g >> 1)) + 8 * (g & 1)); const u32x2 o = *tp; u32x2 w;
                w.x = cvt_pk_bf16(cd * (bflo(o.x) + acc2[eb][0]), cd * (bfhi(o.x) + acc2[eb][1])); w.y = cvt_pk_bf16(cd * (bflo(o.y) + acc2[eb][2]), cd * (bfhi(o.y) + acc2[eb][3])); *tp = w; }
        }
        bf16x8 qf[4];
#pragma unroll
        for (int ks = 0; ks < 4; ++ks) qf[ks] = row_frag(tq, lane, wave, ks);
        u32x2 pk[8];
#pragma unroll
        for (int mb = 0; mb < 8; ++mb) { f32x4 s = (f32x4){0.f, 0.f, 0.f, 0.f};
            if (mb <= wave) {
#pragma unroll
            for (int ks = 0; ks < 4; ++ks) s = __builtin_amdgcn_mfma_f32_16x16x32_bf16(row_frag(tk, lane, mb, ks), qf[ks], s, 0, 0, 0); }
            const int c = 16 * wave + l15, m0 = 16 * mb + 4 * g;
#pragma unroll
            for (int r = 0; r < 4; ++r) if (m0 + r > c) s[r] = 0.f;
            pk[mb].x = cvt_pk_bf16(s[0], s[1]); pk[mb].y = cvt_pk_bf16(s[2], s[3]); __builtin_amdgcn_sched_barrier(0); }
        __syncthreads();
#pragma unroll
        for (int mb = 0; mb < 8; ++mb) *(LAS u32x2*)(tk + offb(16 * wave + l15, 2 * mb + (g >> 1)) + 8 * (g & 1)) = pk[mb];
#pragma unroll 1
        for (int ks = 0; ks < 4; ++ks) { if (2 * ks <= wave) {
            const bf16x8 pf = row_frag(tk, lane, wave, ks); bf16x8 vf[8]; tr_frag8(lbase + 65536, lane, ks, vf);
#pragma unroll
            for (int eb = 0; eb < 8; ++eb) acc[eb] = __builtin_amdgcn_mfma_f32_16x16x32_bf16(pf, vf[eb], acc[eb], 0, 0, 0); } }
#pragma unroll
        for (int r = 0; r < 4; ++r) { float s = 0.f;
#pragma unroll
            for (int eb = 0; eb < 8; ++eb) s += acc[eb][r];
            s += __shfl_xor(s, 1); s += __shfl_xor(s, 2); s += __shfl_xor(s, 4); s += __shfl_xor(s, 8);
            const float mu = s * (1.0f / 128.0f); float q = 0.f;
#pragma unroll
            for (int eb = 0; eb < 8; ++eb) { const float d = acc[eb][r] - mu; q += d * d; }
            q += __shfl_xor(q, 1); q += __shfl_xor(q, 2); q += __shfl_xor(q, 4); q += __shfl_xor(q, 8);
            const float rstd = rsqrtf(q * (1.0f / 128.0f) + 1e-6f);
            const int c = 16 * wave + 4 * g + r;
#pragma unroll
            for (int eb = 0; eb < 8; ++eb) { const int e = 16 * eb + l15;
                *(LAS bf16_t*)(tq + offb(c, e >> 3) + (e & 7) * 2) = (bf16_t)(cvt_pk_bf16((acc[eb][r] - mu) * rstd, 0.f) & 0xffffu); } }
#pragma unroll
        for (int i = 0; i < 4; ++i) { const int idx = lane + 64 * i, c = 16 * wave + (idx >> 4), ch = idx & 15, p = n * 128 + c - 112;
            if (p >= 0) { const size_t zr = (size_t)zrow_of(b, p) * NIN;
                const u32x4 y = *(const LAS u32x4*)(tq + offb(c, ch)); const u32x4 gg = *(const u32x4*)(z + zr + 1536 + h * 128 + ch * 8);
                u32x4 o;
#pragma unroll
                for (int k = 0; k < 4; ++k) o[k] = cvt_pk_bf16(bflo(y[k]) * silu_f(bflo(gg[k])), bfhi(y[k]) * silu_f(bfhi(gg[k])));
                *(u32x4*)(z + zr + h * 128 + ch * 8) = o; } }
        __syncthreads();
        }
    }
}
__device__ __forceinline__ void phase_final(const Params& P) {
    int tid_ = threadIdx.x; asm volatile("" : "+v"(tid_));
    const int tid = tid_, lane = tid & 63, wave = tid >> 6; const int gw = blockIdx.x * 8 + wave, NGW = gridDim.x * 8;
    const u64* rowsq = (const u64*)(P.ws + WS_ROWSQ) + (size_t)6 * TM; const f32x4* gn = (const f32x4*)P.in[17];
    f32x4 gv[4];
#pragma unroll
    for (int j = 0; j < 4; ++j) gv[j] = gn[lane + 64 * j];
    for (int m = gw; m < TS; m += NGW) { const float rs = rsqrtf(rq2f(rowsq[m]) * (1.0f / DM) + 1e-6f); f32x4* o = (f32x4*)(P.out + (size_t)m * DM);
#pragma unroll
        for (int j = 0; j < 4; ++j) o[lane + 64 * j] = o[lane + 64 * j] * rs * gv[j]; }
}

__global__ void __launch_bounds__(512, 2) mk_fwd(Params P) {
    extern __shared__ __attribute__((aligned(16))) unsigned char lds_raw[];
    LAS unsigned char* lds = (LAS unsigned char*)lds_raw;
    cg::grid_group grid = cg::this_grid();
    const int lo = P.ph_lo, hi = P.ph_hi;
    unsigned char* ws = P.ws;
    u64* rowsq = (u64*)(ws + WS_ROWSQ); float* hmeta = (float*)(ws + WS_HMETA); bf16_t* hb = (bf16_t*)(ws + WS_HB); bf16_t* z = (bf16_t*)(ws + WS_Z);
    const float* tab = (const float*)(ws + WS_TAB);
#define IN(k) (lo <= (k) && (k) < hi)
    { LAS unsigned* stw = (LAS unsigned*)(lds + 131072); if (threadIdx.x < 4) stw[threadIdx.x] = 0u; }
    __syncthreads();
    const XcdBarrier xbar = xcd_barrier_post((unsigned*)(ws + WS_BAR), (volatile LAS unsigned*)(lds + 131072));
    if (lo < 0) grid.sync();
#define SEAM(k) do { if ((k) + 1 < hi) xcd_barrier(xbar); } while (0)
    if (IN(0)) { if (PHMASK & 1) phase_prep(P, lds); SEAM(0); }
    for (int l = 0; l < 2; ++l) {
        const int pb = 1 + 10 * l; unsigned char* wl = ws + WS_W + l * W_LAYER;
        pg8::StaticOrder S;
        if (IN(pb + 0)) { pg8::Gemm g{hb, (const bf16_t*)(wl + W_W1), TS, 2 * FF, DM, DM}; S.init(TS, 2 * FF, gridDim.x, blockIdx.x);
            if (PHMASK & 256) skinny<0>(lds, SkArgs{hb + (size_t)TS * DM, DM, (const bf16_t*)(wl + W_W1), DM, rowsq + (size_t)(3 * l) * TM, nullptr, hmeta, hb, z, tab, 0.f});
            EpiUp E{rowsq + (size_t)(3 * l) * TM, z}; if (PHMASK & 2) pg8::gemm_phase(lds, g, S, E); SEAM(pb + 0); }
        if (IN(pb + 1)) { pg8::Gemm g{z, (const bf16_t*)(wl + W_W1D), TS, DM, FF, FF}; S.init(TS, DM, gridDim.x, blockIdx.x);
            if (PHMASK & 256) skinny<1>(lds, SkArgs{z + (size_t)TS * FF, FF, (const bf16_t*)(wl + W_W1D), FF, nullptr, rowsq + (size_t)(3 * l + 1) * TM, hmeta, hb, z, tab, 0.5f});
            EpiDown<false, false> E{l == 0 ? P.in[0] : P.out, nullptr, hb, rowsq + (size_t)(3 * l + 1) * TM, 0.5f}; if (PHMASK & 4) pg8::gemm_phase(lds, g, S, E); SEAM(pb + 1); }
        if (IN(pb + 2)) { pg8::Gemm g{hb, (const bf16_t*)(wl + W_WIN), TS, NIN, DM, DM}; S.init(TS, NIN, gridDim.x, blockIdx.x);
            if (PHMASK & 256) skinny<2>(lds, SkArgs{hb + (size_t)TS * DM, DM, (const bf16_t*)(wl + W_WIN), DM, rowsq + (size_t)(3 * l + 1) * TM, nullptr, hmeta, hb, z, tab, 0.f});
            EpiIn E{rowsq + (size_t)(3 * l + 1) * TM, z, tab}; if (PHMASK & 8) pg8::gemm_phase(lds, g, S, E); SEAM(pb + 2); }
        if (IN(pb + 3)) { if (PHMASK & 16) phase_kv(P, lds); SEAM(pb + 3); }
        if (IN(pb + 5)) { if (PHMASK & 64) phase_ret<false>(P, lds); SEAM(pb + 5); }
        if (IN(pb + 6)) { pg8::Gemm g{z, (const bf16_t*)(wl + W_WRP), TS, DM, DM, NIN}; S.init(TS, DM, gridDim.x, blockIdx.x);
            if (PHMASK & 256) skinny<3>(lds, SkArgs{z + (size_t)TS * NIN, NIN, (const bf16_t*)(wl + W_WRP), DM, nullptr, nullptr, hmeta, hb, z, tab, 0.f});
            EpiMix E{z}; if (PHMASK & 128) pg8::gemm_phase(lds, g, S, E); SEAM(pb + 6); }
        if (IN(pb + 7)) { pg8::Gemm g{z + 1024, (const bf16_t*)(wl + W_WO), TS, DM, DM, NIN}; S.init(TS, DM, gridDim.x, blockIdx.x);
            if (PHMASK & 256) skinny<1>(lds, SkArgs{z + (size_t)TS * NIN + 1024, NIN, (const bf16_t*)(wl + W_WO), DM, nullptr, rowsq + (size_t)(3 * l + 2) * TM, hmeta, hb, z, tab, 1.0f});
            EpiDown<true, false> E{nullptr, nullptr, hb, rowsq + (size_t)(3 * l + 2) * TM, 1.0f}; pg8::gemm_phase(lds, g, S, E); SEAM(pb + 7); }
        if (IN(pb + 8)) { pg8::Gemm g{hb, (const bf16_t*)(wl + W_W2), TS, 2 * FF, DM, DM}; S.init(TS, 2 * FF, gridDim.x, blockIdx.x);
            if (PHMASK & 256) skinny<0>(lds, SkArgs{hb + (size_t)TS * DM, DM, (const bf16_t*)(wl + W_W2), DM, rowsq + (size_t)(3 * l + 2) * TM, nullptr, hmeta, hb, z, tab, 0.f});
            EpiUp E{rowsq + (size_t)(3 * l + 2) * TM, z}; pg8::gemm_phase(lds, g, S, E); SEAM(pb + 8); }
        if (IN(pb + 9)) { pg8::Gemm g{z, (const bf16_t*)(wl + W_W2D), TS, DM, FF, FF}; S.init(TS, DM, gridDim.x, blockIdx.x);
            if (PHMASK & 256) skinny<1>(lds, SkArgs{z + (size_t)TS * FF, FF, (const bf16_t*)(wl + W_W2D), FF, nullptr, rowsq + (size_t)(3 * l + 3) * TM, hmeta, hb, z, tab, 0.5f});
            const bool fuse_final = (l == 1) && (gridDim.x == 256);
            if (fuse_final) { EpiFinal E{P.out, hb, rowsq + (size_t)6 * TM, (unsigned*)(ws + WS_CNT), P.in[17]}; pg8::gemm_phase(lds, g, S, E); }
            else { EpiDown<true, true> E{nullptr, P.out, hb, rowsq + (size_t)(3 * l + 3) * TM, 0.5f}; pg8::gemm_phase(lds, g, S, E); }
            if (l == 1 && !fuse_final) { xcd_barrier(xbar); phase_final(P); }
            SEAM(pb + 9); }
    }
#undef IN
#undef SEAM
}

extern "C" void kernel_launch(void* const* d_in, const int* in_sizes, int n_in, void* d_out, int out_size, void* d_ws, size_t ws_size, hipStream_t stream) {
    static int grid = 0;
    if (grid == 0) {
        if (n_in != 18 || in_sizes[0] != TS * DM || out_size != TS * DM || ws_size < WS_END) { fprintf(stderr, "kernel_launch: unexpected shapes (n_in %d, in0 %d, out %d, ws %zu < %zu)\n", n_in, n_in > 0 ? in_sizes[0] : -1, out_size, ws_size, (size_t)WS_END); grid = -1; return; }
        int dev = 0, cus = 0, per_cu = 0;
        hipGetDevice(&dev); hipDeviceGetAttribute(&cus, hipDeviceAttributeMultiprocessorCount, dev);
        if (hipFuncSetAttribute((const void*)mk_fwd, hipFuncAttributeMaxDynamicSharedMemorySize, LDS_BYTES) != hipSuccess) { fprintf(stderr, "kernel_launch: hipFuncSetAttribute failed\n"); grid = -1; return; }
        if (hipOccupancyMaxActiveBlocksPerMultiprocessor(&per_cu, (const void*)mk_fwd, 512, LDS_BYTES) != hipSuccess || per_cu < 1) { fprintf(stderr, "kernel_launch: occupancy query says %d blocks/CU\n", per_cu); per_cu = 1; }
        (void)hipGetLastError();
        grid = cus * per_cu;
    }
    if (grid < 0) return;
    Params p{};
    for (int i = 0; i < 18; ++i) p.in[i] = (const float*)d_in[i];
    p.out = (float*)d_out; p.ws = (unsigned char*)d_ws;
#if MK_MULTI
    for (int ph = 0; ph < NPH; ++ph) { p.ph_lo = ph; p.ph_hi = ph + 1; hipLaunchKernelGGL(mk_fwd, dim3(grid), dim3(512), LDS_BYTES, stream, p); }
#else
    p.ph_lo = 0; p.ph_hi = NPH;
    (void)hipMemsetAsync((unsigned char*)d_ws + WS_BAR, 0, XCD_BAR_WORDS * 4, stream);
    void* args[] = {&p};
    hipError_t e = hipLaunchCooperativeKernel((const void*)mk_fwd, dim3(grid), dim3(512), args, LDS_BYTES, stream);
    if (e != hipSuccess) fprintf(stderr, "cooperative launch failed: %s (grid %d)\n", hipGetErrorString(e), grid);
#endif
}
```
